# Optimizing an MI355X kernel written in HIP

```python
import math
import numpy as np
import jax
import jax.numpy as jnp
from jax import lax


D_MODEL = 2048
BATCH = 8
SEQ = 2048
DEPTH = 2

MEM_LEN = 256
MIX_WIDTH = D_MODEL
MIX_GROUP_WIDTH = MIX_WIDTH // 4
N_MIXERS = 4
HEAD_DIM = 64
Q_BLOCK = 128
ROPE_THETA = 10000.0
LN_EPS = 1e-5
RMS_EPS = 1e-6
SSM_CH = 16
SSM_GROUPS = MIX_GROUP_WIDTH // SSM_CH
SSM_STATE = 64
NSA_HEADS = MIX_GROUP_WIDTH // HEAD_DIM
NSA_KV_HEADS = 2
NSA_REP = NSA_HEADS // NSA_KV_HEADS
CMP_LEN = 32
CMP_STRIDE = 16
CMP_HIDDEN = 128
SEL_BLOCK = 64
SEL_TOPN = 8
NSA_WINDOW = 512
SB_HEADS = MIX_GROUP_WIDTH // HEAD_DIM
DIL_HEADS = MIX_GROUP_WIDTH // HEAD_DIM
DIL_CONFIGS = ((128, 1), (512, 4), (2048, 16))
XA_HEADS = 4
XA_HEAD_DIM = 128
XA_WIDTH = XA_HEADS * XA_HEAD_DIM
FFN_HIDDEN = -(-8 * D_MODEL // (3 * 256)) * 256
DEEPNORM_ALPHA = (2 * DEPTH) ** 0.25
DEEPNORM_BETA = (8 * DEPTH) ** -0.25
SSM_WIDTH = SSM_GROUPS * SSM_CH
NSA_Q_WIDTH = NSA_HEADS * HEAD_DIM
NSA_KV_WIDTH = 6 * NSA_KV_HEADS * HEAD_DIM
NSA_GATE_WIDTH = 3 * NSA_HEADS
SB_QKV_WIDTH = 3 * SB_HEADS * HEAD_DIM
DIL_QKV_WIDTH = 3 * DIL_HEADS * HEAD_DIM
IN_WIDTHS = (SSM_WIDTH, NSA_Q_WIDTH, NSA_KV_WIDTH, NSA_GATE_WIDTH, SB_QKV_WIDTH, DIL_QKV_WIDTH)
IN_WIDTH = SSM_WIDTH + NSA_Q_WIDTH + NSA_KV_WIDTH + NSA_GATE_WIDTH + SB_QKV_WIDTH + DIL_QKV_WIDTH

kernel_name = 'hybrid_s5_nsa_stickbreak_dilated_deepnorm'

F32 = jnp.float32


def layer_norm(x, g, b):
    xf = x.astype(F32)
    mu = jnp.mean(xf, -1, keepdims=True)
    xc = xf - mu
    var = jnp.mean(xc * xc, -1, keepdims=True)
    return (xc * lax.rsqrt(var + LN_EPS) * g + b).astype(x.dtype)


def rms_norm(x, g):
    xf = x.astype(F32)
    return (xf * lax.rsqrt(jnp.mean(xf * xf, -1, keepdims=True) + RMS_EPS) * g).astype(x.dtype)


def rope(x, pos):
    half = x.shape[-1] // 2
    inv_freq = ROPE_THETA ** (-jnp.arange(half, dtype=F32) / half)
    ang = pos.astype(F32)[:, None] * inv_freq[None, :]
    cos = jnp.cos(ang)[:, None, :]
    sin = jnp.sin(ang)[:, None, :]
    x1 = x[..., :half].astype(F32)
    x2 = x[..., half:].astype(F32)
    return jnp.concatenate([x1 * cos - x2 * sin, x2 * cos + x1 * sin], -1).astype(x.dtype)


def masked_softmax(s, mask, axis):
    s = jnp.where(mask, s, -jnp.inf)
    m = jnp.max(s, axis=axis, keepdims=True)
    m = jnp.where(jnp.isfinite(m), m, 0.0)
    p = jnp.where(mask, jnp.exp(s - m), 0.0)
    den = jnp.sum(p, axis=axis, keepdims=True)
    return p / jnp.maximum(den, 1e-30), m + jnp.log(den)


def _s5_combine(e1, e2):
    a1r, a1i, b1r, b1i = e1
    a2r, a2i, b2r, b2i = e2
    return (a2r * a1r - a2i * a1i, a2r * a1i + a2i * a1r,
            a2r * b1r - a2i * b1i + b2r, a2r * b1i + a2i * b1r + b2i)


def s5_mixer(u, lam_re, lam_im, log_dt, b_re, b_im, c_re, c_im, d_skip, w_glu, b_glu):
    Bsz, S, _ = u.shape
    uf = u.astype(F32).reshape(Bsz, S, SSM_GROUPS, SSM_CH)
    lr = jnp.minimum(lam_re.astype(F32), -1e-4)
    li = lam_im.astype(F32)
    dt = jnp.exp(log_dt.astype(F32))[:, None]
    mag = jnp.exp(lr * dt)
    a_re = mag * jnp.cos(li * dt)
    a_im = mag * jnp.sin(li * dt)
    den = lr * lr + li * li
    z_re = ((a_re - 1.0) * lr + a_im * li) / den
    z_im = (a_im * lr - (a_re - 1.0) * li) / den
    bb_re = z_re[..., None] * b_re - z_im[..., None] * b_im
    bb_im = z_re[..., None] * b_im + z_im[..., None] * b_re
    bu_re = jnp.einsum('bsgc,gpc->bsgp', uf, bb_re)
    bu_im = jnp.einsum('bsgc,gpc->bsgp', uf, bb_im)
    shape = bu_re.shape
    elems = (jnp.broadcast_to(a_re, shape), jnp.broadcast_to(a_im, shape), bu_re, bu_im)
    _, _, x_re, x_im = lax.associative_scan(_s5_combine, elems, axis=1)
    y = (jnp.einsum('bsgp,gcp->bsgc', x_re, c_re) - jnp.einsum('bsgp,gcp->bsgc', x_im, c_im)
         + d_skip * uf)
    g = jax.nn.gelu(y.reshape(Bsz, S, SSM_WIDTH))
    return g * jax.nn.sigmoid(g @ w_glu + b_glu)


def nsa_mixer(q, k_cmp, v_cmp, k_slc, v_slc, k_win, v_win, gates, cmp_pe, cmp_w1, cmp_w2):
    Bsz, S = q.shape[:2]
    G, R, dh = NSA_KV_HEADS, NSA_REP, HEAD_DIM
    scale = dh ** -0.5
    n_cmp = (S - CMP_LEN) // CMP_STRIDE + 1
    blk_idx = jnp.arange(n_cmp)[:, None] * CMP_STRIDE + jnp.arange(CMP_LEN)[None, :]
    cmp_end = jnp.arange(n_cmp) * CMP_STRIDE + CMP_LEN - 1

    def compress(t, j):
        blocks = t[:, blk_idx] + cmp_pe[j][:, None, :]
        flat = blocks.transpose(0, 1, 3, 2, 4).reshape(Bsz, n_cmp, G, CMP_LEN * dh)
        return jax.nn.gelu(flat @ cmp_w1[j]) @ cmp_w2[j]

    kc = rope(compress(k_cmp, 0), cmp_end)
    vc = compress(v_cmp, 1)

    n_sel = S // SEL_BLOCK
    top_n = min(SEL_TOPN, n_sel)
    ci = np.arange(n_cmp)[:, None] * CMP_STRIDE
    sj = np.arange(n_sel)[None, :] * SEL_BLOCK
    overlap = np.clip(np.minimum(ci + CMP_LEN, sj + SEL_BLOCK) - np.maximum(ci, sj), 0, None) / CMP_LEN
    overlap = jnp.asarray(overlap, dtype=F32)
    ks_blocks = k_slc.reshape(Bsz, n_sel, SEL_BLOCK, G, dh).transpose(0, 3, 1, 2, 4)
    vs_blocks = v_slc.reshape(Bsz, n_sel, SEL_BLOCK, G, dh).transpose(0, 3, 1, 2, 4)
    pad = jnp.zeros((Bsz, NSA_WINDOW, G, dh), k_win.dtype)
    kw_pad = jnp.concatenate([pad, k_win], 1)
    vw_pad = jnp.concatenate([pad, v_win], 1)
    n_qb = S // Q_BLOCK
    qb = q.reshape(Bsz, n_qb, Q_BLOCK, G, R, dh).transpose(1, 0, 2, 3, 4, 5)
    gb = gates.reshape(Bsz, n_qb, Q_BLOCK, G, R, 3).transpose(1, 0, 2, 3, 4, 5)
    b_ix = jnp.arange(Bsz)[:, None, None, None]
    g_ix = jnp.arange(G)[None, :, None, None]
    sel_j = jnp.arange(n_sel)

    def block(args):
        qi, g_blk, blk = args
        t = blk * Q_BLOCK + jnp.arange(Q_BLOCK)
        s_c = jnp.einsum('bqgrd,bcgd->bgrqc', qi, kc).astype(F32) * scale
        p_c, _ = masked_softmax(s_c, cmp_end[None, :] <= t[:, None], -1)
        o_c = jnp.einsum('bgrqc,bcgd->bqgrd', p_c.astype(vc.dtype), vc)
        imp = jnp.einsum('bgrqc,cn->bgqn', p_c, overlap)
        cur = (t // SEL_BLOCK)[:, None]
        imp = jnp.where(sel_j[None, :] * SEL_BLOCK > t[:, None], -jnp.inf, imp)
        forced = (sel_j[None, :] == 0) | (sel_j[None, :] == cur) | (sel_j[None, :] == cur - 1)
        imp = jnp.where(forced, jnp.inf, imp)
        top_val, top_idx = lax.top_k(imp, top_n)
        ks = ks_blocks[b_ix, g_ix, top_idx]
        vs = vs_blocks[b_ix, g_ix, top_idx]
        s_s = jnp.einsum('bqgrd,bgqnkd->bgrqnk', qi, ks).astype(F32) * scale
        key_pos = top_idx[..., None] * SEL_BLOCK + jnp.arange(SEL_BLOCK)
        m_s = (top_val > -jnp.inf)[..., None] & (key_pos <= t[:, None, None])
        p_s, _ = masked_softmax(s_s, m_s[:, :, None], (-2, -1))
        o_s = jnp.einsum('bgrqnk,bgqnkd->bqgrd', p_s.astype(vs.dtype), vs)
        kw = lax.dynamic_slice_in_dim(kw_pad, blk * Q_BLOCK, Q_BLOCK + NSA_WINDOW, axis=1)
        vw = lax.dynamic_slice_in_dim(vw_pad, blk * Q_BLOCK, Q_BLOCK + NSA_WINDOW, axis=1)
        s_w = jnp.einsum('bqgrd,bkgd->bgrqk', qi, kw).astype(F32) * scale
        kpos = blk * Q_BLOCK - NSA_WINDOW + jnp.arange(Q_BLOCK + NSA_WINDOW)
        diff = t[:, None] - kpos[None, :]
        m_w = (kpos[None, :] >= 0) & (diff >= 0) & (diff < NSA_WINDOW)
        p_w, _ = masked_softmax(s_w, m_w, -1)
        o_w = jnp.einsum('bgrqk,bkgd->bqgrd', p_w.astype(vw.dtype), vw)
        return g_blk[..., 0:1] * o_c + g_blk[..., 1:2] * o_s + g_blk[..., 2:3] * o_w

    out = lax.map(block, (qb, gb, jnp.arange(n_qb)))
    return out.transpose(1, 0, 2, 3, 4, 5).reshape(Bsz, S, NSA_HEADS * dh)


def stick_breaking_mixer(q, k, v):
    Bsz, S, H, dh = q.shape
    n_qb = S // Q_BLOCK
    qb = q.reshape(Bsz, n_qb, Q_BLOCK, H, dh).transpose(1, 0, 2, 3, 4)
    kpos = jnp.arange(S)

    def block(args):
        qi, blk = args
        t = blk * Q_BLOCK + jnp.arange(Q_BLOCK)
        z = jnp.einsum('bqhd,bkhd->bhqk', qi, k).astype(F32) * dh ** -0.5
        mask = kpos[None, :] < t[:, None]
        log_fail = jnp.where(mask, jax.nn.log_sigmoid(-z), 0.0)
        after = lax.cumsum(log_fail, axis=3, reverse=True) - log_fail
        w = jnp.where(mask, jnp.exp(jax.nn.log_sigmoid(z) + after), 0.0)
        return jnp.einsum('bhqk,bkhd->bqhd', w.astype(v.dtype), v)

    out = lax.map(block, (qb, jnp.arange(n_qb)))
    return out.transpose(1, 0, 2, 3, 4).reshape(Bsz, S, H * dh)


def dilated_branch(q, k, v, window, dil):
    Bsz, S, H, dh = q.shape
    L = S // dil
    wd = window // dil
    qlen = Q_BLOCK // dil
    n_b = L // qlen

    def sub(a):
        return a.reshape(Bsz, L, dil, H, dh)

    qs = sub(q).reshape(Bsz, n_b, qlen, dil, H, dh).transpose(1, 0, 2, 3, 4, 5)
    pad = jnp.zeros((Bsz, wd, dil, H, dh), k.dtype)
    ks = jnp.concatenate([pad, sub(k)], 1)
    vs = jnp.concatenate([pad, sub(v)], 1)
    i = jnp.arange(qlen)[:, None]
    j = jnp.arange(qlen + wd)[None, :]
    band = (j >= i) & (j <= i + wd)

    def block(args):
        qi, blk = args
        kb = lax.dynamic_slice_in_dim(ks, blk * qlen, qlen + wd, axis=1)
        vb = lax.dynamic_slice_in_dim(vs, blk * qlen, qlen + wd, axis=1)
        s = jnp.einsum('bqrhd,bkrhd->brhqk', qi, kb).astype(F32) * dh ** -0.5
        valid = band & (blk * qlen + j - wd >= 0)
        p, lse = masked_softmax(s, valid, -1)
        o = jnp.einsum('brhqk,bkrhd->bqrhd', p.astype(vb.dtype), vb)
        return o, lse[..., 0]

    o, lse = lax.map(block, (qs, jnp.arange(n_b)))
    o = o.transpose(1, 0, 2, 3, 4, 5).reshape(Bsz, S, H, dh)
    lse = lse.transpose(1, 0, 4, 2, 3).reshape(Bsz, S, H)
    return o, lse


def dilated_mixer(q, k, v):
    Bsz, S, H, dh = q.shape
    outs, lses = [], []
    for window, dil in DIL_CONFIGS:
        o, lse = dilated_branch(q, k, v, window, dil)
        outs.append(o.astype(F32))
        lses.append(lse)
    wts = jax.nn.softmax(jnp.stack(lses, 0), axis=0)
    out = jnp.einsum('cbsh,cbshd->bshd', wts, jnp.stack(outs, 0))
    return out.reshape(Bsz, S, H * dh)


def hybrid_mixer(h, w_in, lam_re, lam_im, log_dt, b_re, b_im, c_re, c_im, d_skip, w_glu, b_glu,
                 cmp_pe, cmp_w1, cmp_w2, norm_g, w_out):
    Bsz, S, _ = h.shape
    proj = h @ w_in
    offs = np.cumsum(IN_WIDTHS)[:-1].tolist()
    u, nq, nkv, ngate, sb_qkv, dil_qkv = jnp.split(proj, offs, axis=-1)
    pos = jnp.arange(S)
    y_a = s5_mixer(u, lam_re, lam_im, log_dt, b_re, b_im, c_re, c_im, d_skip, w_glu, b_glu)
    q = rope(nq.reshape(Bsz, S, NSA_HEADS, HEAD_DIM), pos)
    kv = nkv.reshape(Bsz, S, 6, NSA_KV_HEADS, HEAD_DIM)
    gates = jax.nn.sigmoid(ngate.astype(F32)).reshape(Bsz, S, NSA_HEADS, 3)
    y_b = nsa_mixer(q, kv[:, :, 0], kv[:, :, 1], rope(kv[:, :, 2], pos), kv[:, :, 3],
                    rope(kv[:, :, 4], pos), kv[:, :, 5], gates, cmp_pe, cmp_w1, cmp_w2)
    sqkv = sb_qkv.reshape(Bsz, S, 3, SB_HEADS, HEAD_DIM)
    y_c = stick_breaking_mixer(sqkv[:, :, 0], sqkv[:, :, 1], sqkv[:, :, 2])
    dqkv = dil_qkv.reshape(Bsz, S, 3, DIL_HEADS, HEAD_DIM)
    y_d = dilated_mixer(rope(dqkv[:, :, 0], pos), rope(dqkv[:, :, 1], pos), dqkv[:, :, 2])
    ys = jnp.stack([y_a.astype(F32), y_b.astype(F32), y_c.astype(F32), y_d.astype(F32)], axis=2)
    ys = rms_norm(ys, norm_g)
    return ys.reshape(Bsz, S, MIX_WIDTH).astype(h.dtype) @ w_out


def memory_cross_attention(h, mem, wq, wkv, wo):
    Bsz, S, _ = h.shape
    M = mem.shape[1]
    q = (h @ wq).reshape(Bsz, S, XA_HEADS, XA_HEAD_DIM)
    kv = (mem @ wkv).reshape(Bsz, M, 2, XA_HEADS, XA_HEAD_DIM)
    s = jnp.einsum('bshd,bmhd->bhsm', q, kv[:, :, 0]).astype(F32) * XA_HEAD_DIM ** -0.5
    p = jax.nn.softmax(s, axis=-1)
    o = jnp.einsum('bhsm,bmhd->bshd', p.astype(kv.dtype), kv[:, :, 1])
    return o.reshape(Bsz, S, XA_WIDTH) @ wo


def swiglu_ffn(h, wg, wu, wd):
    return (jax.nn.silu(h @ wg) * (h @ wu)) @ wd


def setup_inputs(seed: int = 0) -> dict:
    key = jax.random.key(seed)
    keys = iter(jax.random.split(key, 40))

    def nrm(shape, scale):
        return jax.random.normal(next(keys), shape, F32) * scale

    L, D = DEPTH, D_MODEL
    G, P, C = SSM_GROUPS, SSM_STATE, SSM_CH
    return {
        'x': nrm((BATCH, SEQ, D), 1.0),
        'mem': nrm((BATCH, MEM_LEN, D), 1.0),
        'ln_in_g': 1.0 + nrm((D,), 0.01),
        'ln_in_b': nrm((D,), 0.01),
        'w_in': nrm((L, D, IN_WIDTH), D ** -0.5),
        's5_lambda_re': -0.5 + nrm((L, G, P), 0.01),
        's5_lambda_im': math.pi * jnp.arange(P, dtype=F32) + nrm((L, G, P), 0.01),
        's5_log_dt': jax.random.uniform(next(keys), (L, G), F32, math.log(1e-3), math.log(1e-1)),
        's5_b_re': nrm((L, G, P, C), (2 * C) ** -0.5),
        's5_b_im': nrm((L, G, P, C), (2 * C) ** -0.5),
        's5_c_re': nrm((L, G, C, P), (2 * P) ** -0.5),
        's5_c_im': nrm((L, G, C, P), (2 * P) ** -0.5),
        's5_d': nrm((L, G, C), 1.0),
        's5_w_glu': nrm((L, SSM_WIDTH, SSM_WIDTH), SSM_WIDTH ** -0.5),
        's5_b_glu': nrm((L, SSM_WIDTH), 0.01),
        'nsa_cmp_pe': nrm((L, 2, CMP_LEN, HEAD_DIM), 0.02),
        'nsa_cmp_w1': nrm((L, 2, CMP_LEN * HEAD_DIM, CMP_HIDDEN), (CMP_LEN * HEAD_DIM) ** -0.5),
        'nsa_cmp_w2': nrm((L, 2, CMP_HIDDEN, HEAD_DIM), CMP_HIDDEN ** -0.5),
        'mix_norm_g': 1.0 + nrm((L, N_MIXERS, MIX_GROUP_WIDTH), 0.01),
        'w_out': nrm((L, MIX_WIDTH, D), MIX_WIDTH ** -0.5 * DEEPNORM_BETA),
        'ln1_g': 1.0 + nrm((L, D), 0.01),
        'ln1_b': nrm((L, D), 0.01),
        'xa_wq': nrm((L, D, XA_WIDTH), D ** -0.5),
        'xa_wkv': nrm((L, D, 2 * XA_WIDTH), D ** -0.5),
        'xa_wo': nrm((L, XA_WIDTH, D), XA_WIDTH ** -0.5 * DEEPNORM_BETA),
        'ln2_g': 1.0 + nrm((L, D), 0.01),
        'ln2_b': nrm((L, D), 0.01),
        'ffn_w_gate': nrm((L, D, FFN_HIDDEN), D ** -0.5),
        'ffn_w_up': nrm((L, D, FFN_HIDDEN), D ** -0.5),
        'ffn_w_down': nrm((L, FFN_HIDDEN, D), FFN_HIDDEN ** -0.5 * DEEPNORM_BETA),
        'ln3_g': 1.0 + nrm((L, D), 0.01),
        'ln3_b': nrm((L, D), 0.01),
    }


def reference(x, mem, ln_in_g, ln_in_b, w_in, s5_lambda_re, s5_lambda_im, s5_log_dt, s5_b_re, s5_b_im,
              s5_c_re, s5_c_im, s5_d, s5_w_glu, s5_b_glu, nsa_cmp_pe, nsa_cmp_w1, nsa_cmp_w2, mix_norm_g,
              w_out, ln1_g, ln1_b, xa_wq, xa_wkv, xa_wo, ln2_g, ln2_b, ffn_w_gate, ffn_w_up, ffn_w_down,
              ln3_g, ln3_b):
    h = layer_norm(x, ln_in_g, ln_in_b)
    for l in range(DEPTH):
        f = hybrid_mixer(h, w_in[l], s5_lambda_re[l], s5_lambda_im[l], s5_log_dt[l], s5_b_re[l], s5_b_im[l],
                         s5_c_re[l], s5_c_im[l], s5_d[l], s5_w_glu[l], s5_b_glu[l], nsa_cmp_pe[l],
                         nsa_cmp_w1[l], nsa_cmp_w2[l], mix_norm_g[l], w_out[l])
        h = layer_norm(DEEPNORM_ALPHA * h + f, ln1_g[l], ln1_b[l])
        f = memory_cross_attention(h, mem, xa_wq[l], xa_wkv[l], xa_wo[l])
        h = layer_norm(DEEPNORM_ALPHA * h + f, ln2_g[l], ln2_b[l])
        f = swiglu_ffn(h, ffn_w_gate[l], ffn_w_up[l], ffn_w_down[l])
        h = layer_norm(DEEPNORM_ALPHA * h + f, ln3_g[l], ln3_b[l])
    return h
```

```cpp
#include <hip/hip_runtime.h>
#include <hip/hip_cooperative_groups.h>
#include <cstdio>
#include <cstdint>
namespace cg = cooperative_groups;

#define DI __device__ __forceinline__
#define LAS __attribute__((address_space(3)))
typedef unsigned short bf16_t;
typedef short bf16x8 __attribute__((ext_vector_type(8)));
typedef short s16x4 __attribute__((ext_vector_type(4)));
typedef float f32x2 __attribute__((ext_vector_type(2)));
typedef float f32x4 __attribute__((ext_vector_type(4)));
typedef float f32x16 __attribute__((ext_vector_type(16)));
typedef unsigned u32x2 __attribute__((ext_vector_type(2)));
typedef unsigned u32x4 __attribute__((ext_vector_type(4)));
typedef __bf16 bf16x2_t __attribute__((ext_vector_type(2)));

constexpr int DM = 2048, BATCH = 8, SEQ = 2048, MTOK = BATCH * SEQ, DEPTH = 2;
constexpr int MEMLEN = 256, FFH = 5632, INW = 4888;
constexpr int PJW = 3840;
constexpr int VTR = 1280;
constexpr int NCMP = 127;
constexpr float ALPHA = 1.4142135623730951f;
constexpr float LN_EPS = 1e-5f, RMS_EPS = 1e-6f;
constexpr int C_U = 0, C_NQ = 512, C_KCMP = 1024, C_VCMP = 1152, C_KSLC = 1280, C_KWIN = 1408, C_SBQ = 1536, C_SBK = 2048, C_DQ = 2560, C_DK = 3072, C_GATE = 3584;
constexpr int R_VSLC = 0, R_VWIN = 128, R_SBV = 256, R_DV = 768;

constexpr size_t al256(size_t x) { return (x + 255) & ~(size_t)255; }
constexpr size_t WS_ROPE = 0;
constexpr size_t WS_WIN = al256(WS_ROPE + 2048 * 32 * 2 * 4);
constexpr size_t WS_WINV = WS_WIN + (size_t)PJW * DM * 2;
constexpr size_t WS_WOUT = WS_WINV + (size_t)VTR * DM * 2;
constexpr size_t WS_WQ = WS_WOUT + (size_t)DM * DM * 2;
constexpr size_t WS_WKV = WS_WQ + (size_t)512 * DM * 2;
constexpr size_t WS_WO = WS_WKV + (size_t)1024 * DM * 2;
constexpr size_t WS_WGLU = WS_WO + (size_t)DM * 512 * 2;
constexpr size_t WS_WC1 = WS_WGLU + (size_t)512 * 512 * 2;

constexpr size_t WS_OCB = WS_WIN;
static_assert((size_t)MTOK * 512 * 2 <= WS_WOUT - WS_WIN, "aliases over weights");
constexpr size_t WS_HF = WS_WC1 + (size_t)256 * DM * 2;
constexpr size_t WS_HB = WS_HF + (size_t)MTOK * DM * 4;
constexpr size_t WS_BIG = WS_HB + (size_t)MTOK * DM * 2;
constexpr size_t WS_PJ = WS_BIG;
constexpr size_t WS_VT = WS_PJ + (size_t)MTOK * PJW * 2;
constexpr size_t WS_CMPA = WS_VT + (size_t)VTR * MTOK * 2;
constexpr size_t WS_GA = WS_WIN;
constexpr size_t WS_ACT = WS_BIG;
constexpr size_t BIG_BYTES = (size_t)MTOK * FFH * 2;
static_assert(WS_CMPA + (size_t)4096 * DM * 2 <= WS_BIG + BIG_BYTES, "big union");
constexpr size_t WS_YS = WS_BIG + BIG_BYTES;
constexpr size_t WS_QX = WS_YS;
constexpr size_t WS_OX = WS_YS + (size_t)MTOK * 512 * 2;
constexpr size_t WS_WGU = WS_HF + (size_t)MTOK * DM * 2;
static_assert((size_t)2 * FFH * DM * 2 <= (size_t)MTOK * DM * 2, "WGU fits in the upper half of HF");
constexpr size_t WS_MEMB = WS_YS + (size_t)MTOK * DM * 2;
constexpr size_t WS_KX = WS_MEMB + (size_t)2048 * DM * 2;
constexpr size_t WS_KXT = WS_KX + (size_t)2048 * 1024 * 2;
constexpr size_t WS_HC = WS_KXT + (size_t)1024 * 2048 * 2;
constexpr size_t WS_KC = WS_HC + (size_t)4096 * 256 * 2;
constexpr size_t WS_VCT = WS_KC + (size_t)8 * 2 * 128 * 64 * 2;
constexpr size_t WS_SEL = WS_VCT + (size_t)8 * 2 * 64 * 128 * 2;
constexpr size_t WS_S5E = WS_SEL + (size_t)MTOK * 2 * 4;
constexpr size_t WS_BAR = WS_S5E + (size_t)8 * 32 * 32 * 64 * 8;
constexpr size_t WS_BAR_BYTES = 16384;
constexpr size_t WS_WD = WS_BAR + WS_BAR_BYTES;
constexpr size_t WS_END = WS_WD + (size_t)DM * FFH * 2;

constexpr int LDS_BYTES = 131072 + 8192;

DI float bf2f(bf16_t v) { return __builtin_bit_cast(float, (unsigned)v << 16); }
DI unsigned pk2(float lo, float hi) { f32x2 v = {lo, hi}; bf16x2_t b = __builtin_convertvector(v, bf16x2_t); return __builtin_bit_cast(unsigned, b); }
DI bf16_t f2bf(float f) { return (bf16_t)(pk2(f, 0.f) & 0xffffu); }
DI float xorl(float v, int lane, int m) { return __builtin_bit_cast(float, __builtin_amdgcn_ds_bpermute((lane ^ m) << 2, __builtin_bit_cast(int, v))); }
DI float wave_sum(float v, int lane) {
#pragma unroll
    for (int o = 1; o < 64; o <<= 1) v += xorl(v, lane, o);
    return v;
}
DI float sigmoidf_(float x) { return 1.f / (1.f + __expf(-x)); }
DI float gelu_tanh(float x) { const float u = 0.7978845608028654f * (x + 0.044715f * x * x * x); return x / (1.f + __expf(-2.f * u)); }
DI float opq(float x) { asm volatile("" : "+s"(x)); return x; }
DI void sincos_acc(float x, float& s, float& c) {
    const float k = rintf(x * 0.63661977236758134308f);
    float r = fmaf(-k, 1.5707963705062866f, x); r = fmaf(-k, -4.371138828673793e-08f, r); r = fmaf(-k, -1.7763568394002505e-15f, r);
    const int q = (int)k & 3; const float r2 = r * r;
    const float sp = fmaf(r * r2, fmaf(r2, fmaf(r2, opq(-1.9515295891e-4f), opq(8.3321608736e-3f)), opq(-1.6666654611e-1f)), r);
    const float cp = fmaf(r2 * r2, fmaf(r2, fmaf(r2, opq(2.443315711809948e-5f), opq(-1.388731625493765e-3f)), opq(4.166664568298827e-2f)), fmaf(r2, -0.5f, 1.0f));
    float sv, cv;
    if (q == 0) { sv = sp; cv = cp; } else if (q == 1) { sv = cp; cv = -sp; } else if (q == 2) { sv = -sp; cv = -cp; } else { sv = -cp; cv = sp; }
    s = sv; c = cv;
}

namespace pg8 {
constexpr int BM = 256, BK = 64, HALF = 128, HTB = HALF * BK * 2, NXCD = 8, WGM = 8;
__host__ __device__ __forceinline__ int lds_byte(int r, int c) { const int st = (r >> 4) * 2 + (c >> 5), rr = r & 15, cc = c & 31, ob = rr * 64 + cc * 2; return st * 1024 + (ob ^ (((ob >> 9) & 1) << 5)); }
__host__ __device__ __forceinline__ void stage_rc(int b, int& R, int& C) { const int st = b / 1024, sb = b % 1024, swz = sb ^ (((sb >> 9) & 1) << 5); R = (st >> 1) * 16 + swz / 64; C = (st & 1) * 32 + (swz % 64) / 2; }
__host__ __device__ __forceinline__ int perm32(int rho) { const int n = rho >> 4, i = rho & 15; return 8 * (i >> 2) + 4 * n + (i & 3); }
struct Unit { int pm, pn; };
struct Gemm { const bf16_t* A; const bf16_t* Bt; int M, N, K; };
struct StaticOrder {
    int nM, nN, nwg, G, c;
    __device__ void init(int M, int N, int G_, int c_) { nM = M / BM; nN = N / BM; nwg = nM * nN; G = G_; c = c_; }
    __device__ bool next(int i, Unit& u) const {
        const long L = (long)i * G + c; if (L >= nwg) return false;
        int wgid = (int)L; { const int q = nwg / NXCD, r = nwg % NXCD, xcd = wgid % NXCD, off = wgid / NXCD; wgid = (xcd < r ? xcd * (q + 1) : r * (q + 1) + (xcd - r) * q) + off; }
        const int nig = WGM * nN, gid = wgid / nig, fm = gid * WGM, gsz = (nM - fm) < WGM ? (nM - fm) : WGM;
        u.pm = fm + ((wgid % nig) % gsz); u.pn = (wgid % nig) / gsz; return true;
    }
    DI void a_ready(const Unit&) const {}
    DI void done(const Unit&) const {}
};

struct EpiAny {
    static constexpr bool PERM = true, AFTER_DRAIN = false;
    int mode; void* out; int ldc; const void* aux1; const void* aux2;
    DI void operator()(const f32x4 (&acc)[2][2][4][2], const Unit& u, int wr, int wc, int fr, int fq) const {
        const int row0 = u.pm * BM + wr * 64 + fr;
        if (mode <= 1) {
            bf16_t* O = (bf16_t*)out; const int col0 = u.pn * BM + wc * 32 + 8 * fq;
#pragma unroll
            for (int ai = 0; ai < 2; ++ai)
#pragma unroll
                for (int m = 0; m < 4; ++m) { bf16_t* rowp = O + (size_t)(row0 + ai * HALF + m * 16) * ldc + col0;
#pragma unroll
                    for (int bj = 0; bj < 2; ++bj) { f32x4 v0 = acc[ai][bj][m][0], v1 = acc[ai][bj][m][1];
                        if (mode == 1) {
#pragma unroll
                            for (int j = 0; j < 4; ++j) { v0[j] = gelu_tanh(v0[j]); v1[j] = gelu_tanh(v1[j]); } }
                        u32x4 w; w.x = pk2(v0[0], v0[1]); w.y = pk2(v0[2], v0[3]); w.z = pk2(v1[0], v1[1]); w.w = pk2(v1[2], v1[3]);
                        *(u32x4*)(rowp + bj * HALF) = w; } }
        } else if (mode == 2) {
            bf16_t* H = (bf16_t*)out; const bf16_t* HBp = (const bf16_t*)aux1; const int col0 = u.pn * BM + wc * 32 + 8 * fq;
#pragma unroll
            for (int ai = 0; ai < 2; ++ai)
#pragma unroll
                for (int m = 0; m < 4; ++m) { const size_t ro = (size_t)(row0 + ai * HALF + m * 16) * ldc + col0;
#pragma unroll
                    for (int bj = 0; bj < 2; ++bj) { const bf16x8 hv = *(const bf16x8*)(HBp + ro + bj * HALF); f32x4 a, b;
#pragma unroll
                        for (int j = 0; j < 4; ++j) { a[j] = bf2f((bf16_t)hv[j]) * ALPHA + acc[ai][bj][m][0][j]; b[j] = bf2f((bf16_t)hv[4 + j]) * ALPHA + acc[ai][bj][m][1][j]; }
                        u32x4 w; w.x = pk2(a[0], a[1]); w.y = pk2(a[2], a[3]); w.z = pk2(b[0], b[1]); w.w = pk2(b[2], b[3]);
                        *(u32x4*)(H + ro + bj * HALF) = w; } }
        } else if (mode == 3) {
            bf16_t* O = (bf16_t*)out; const int col0 = u.pn * HALF + wc * 32 + 8 * fq;
#pragma unroll
            for (int ai = 0; ai < 2; ++ai)
#pragma unroll
                for (int m = 0; m < 4; ++m) { bf16_t* rowp = O + (size_t)(row0 + ai * HALF + m * 16) * ldc + col0;
                    f32x4 g0 = acc[ai][0][m][0], g1 = acc[ai][0][m][1], u0 = acc[ai][1][m][0], u1 = acc[ai][1][m][1];
#pragma unroll
                    for (int j = 0; j < 4; ++j) { g0[j] = g0[j] * sigmoidf_(g0[j]) * u0[j]; g1[j] = g1[j] * sigmoidf_(g1[j]) * u1[j]; }
                    u32x4 w; w.x = pk2(g0[0], g0[1]); w.y = pk2(g0[2], g0[3]); w.z = pk2(g1[0], g1[1]); w.w = pk2(g1[2], g1[3]);
                    *(u32x4*)rowp = w; }
        } else {
            bf16_t* O = (bf16_t*)out; const bf16_t* G = (const bf16_t*)aux1; const float* bia = (const float*)aux2; const int col0 = u.pn * BM + wc * 32 + 8 * fq;
#pragma unroll
            for (int ai = 0; ai < 2; ++ai)
#pragma unroll
                for (int m = 0; m < 4; ++m) { const int row = row0 + ai * HALF + m * 16;
#pragma unroll
                    for (int bj = 0; bj < 2; ++bj) { const int col = col0 + bj * HALF; f32x4 v0 = acc[ai][bj][m][0], v1 = acc[ai][bj][m][1];
                        const bf16x8 gv = *(const bf16x8*)(G + (size_t)row * 512 + col); const f32x4 b0 = *(const f32x4*)(bia + col), b1 = *(const f32x4*)(bia + col + 4);
#pragma unroll
                        for (int j = 0; j < 4; ++j) { v0[j] = bf2f((bf16_t)gv[j]) * sigmoidf_(v0[j] + b0[j]); v1[j] = bf2f((bf16_t)gv[4 + j]) * sigmoidf_(v1[j] + b1[j]); }
                        u32x4 w; w.x = pk2(v0[0], v0[1]); w.y = pk2(v0[2], v0[3]); w.z = pk2(v1[0], v1[1]); w.w = pk2(v1[2], v1[3]);
                        *(u32x4*)(O + (size_t)row * ldc + col) = w; } }
        }
    }
};

template <class Epi, class Sched, bool ALIGN_EPI = false, bool SP2 = false>
__device__ __forceinline__ void gemm_phase(LAS unsigned char* lds, const Gemm g, const Sched& S, const Epi& E, const int tid) {
    const int wid = __builtin_amdgcn_readfirstlane(tid >> 6), lane = tid & 63, wr = wid >> 2, wc = wid & 3, fr = lane & 15, fq = lane >> 4;
    const int K = g.K, nt = K / BK;
    unsigned voffA[2], voffB[2];
#pragma unroll
    for (int i = 0; i < 2; ++i) { int R, C; stage_rc(tid * 16 + i * 8192, R, C); const int Rb = Epi::PERM ? ((R & ~31) + perm32(R & 31)) : R;
        voffA[i] = (unsigned)(R * K + C) * 2u; voffB[i] = (unsigned)(Rb * K + C) * 2u; }
    const size_t kstep = (size_t)(BK * 2);
    const size_t hstep = (size_t)HALF * K * 2;
    const size_t tstep = 2 * hstep;
    const unsigned ldsw = (unsigned)wid * 1024u;
    const int aoff = lds_byte(wr * 64 + fr, fq * 8), boff = lds_byte(wc * 32 + fr, fq * 8);
#define PG8_SA(b, h) (((b) * 2 + (h)) * HTB)
#define PG8_SB(b, h) ((4 + (b) * 2 + (h)) * HTB)
#define PG8_STAGE(bufoff, gbase, voff) do { _Pragma("unroll") for (int _i = 0; _i < 2; ++_i) \
        __builtin_amdgcn_global_load_lds((const unsigned*)((const char*)(gbase) + (voff)[_i]), (LAS unsigned*)(lds + (bufoff) + ldsw + _i * 8192), 16, 0, 0); } while (0)
#define PG8_LDA(dst, b, h) do { _Pragma("unroll") for (int m = 0; m < 4; ++m) _Pragma("unroll") for (int k = 0; k < 2; ++k) dst[m][k] = *(const LAS bf16x8*)(lds + PG8_SA(b, h) + aoff + m * 2048 + k * 1024); } while (0)
#define PG8_LDB(dst, b, h) do { _Pragma("unroll") for (int n = 0; n < 2; ++n) _Pragma("unroll") for (int k = 0; k < 2; ++k) dst[n][k] = *(const LAS bf16x8*)(lds + PG8_SB(b, h) + boff + n * 2048 + k * 1024); } while (0)
#define PG8_MMA(ai, bj, At, Bt) do { __builtin_amdgcn_s_setprio(1); _Pragma("unroll") for (int m = 0; m < 4; ++m) _Pragma("unroll") for (int n = 0; n < 2; ++n) _Pragma("unroll") for (int k = 0; k < 2; ++k) \
        acc[ai][bj][m][n] = __builtin_amdgcn_mfma_f32_16x16x32_bf16(Bt[n][k], At[m][k], acc[ai][bj][m][n], 0, 0, 0); __builtin_amdgcn_s_setprio(0); } while (0)
#define PG8_WAIT_V(n) asm volatile("s_waitcnt vmcnt(" #n ")" ::: "memory")
#define PG8_WAIT_L(n) asm volatile("s_waitcnt lgkmcnt(" #n ")" ::: "memory")
#define PG8_BAR __builtin_amdgcn_s_barrier()
#define PG8_SCHED __builtin_amdgcn_sched_barrier(0)
    Unit cur, nxt; int ui = 0;
    if (!S.next(0, cur)) return;
    f32x4 acc[2][2][4][2];
#pragma unroll
    for (int a = 0; a < 2; ++a)
#pragma unroll
        for (int b = 0; b < 2; ++b)
#pragma unroll
            for (int m = 0; m < 4; ++m)
#pragma unroll
                for (int n = 0; n < 2; ++n) acc[a][b][m][n] = (f32x4){0.f, 0.f, 0.f, 0.f};
    bf16x8 At[4][2], B0[2][2], B1[2][2];
    const char* cA = (const char*)g.A + (size_t)cur.pm * tstep; const char* cB = (const char*)g.Bt + (size_t)cur.pn * tstep;
    S.a_ready(cur);
    if constexpr (SP2) {
        PG8_STAGE(PG8_SB(0, 0), cB, voffB); PG8_STAGE(PG8_SB(0, 1), cB + hstep, voffB); PG8_STAGE(PG8_SA(0, 0), cA, voffA); PG8_STAGE(PG8_SA(0, 1), cA + hstep, voffA);
        if (wr == 1) PG8_BAR;
        PG8_WAIT_V(2); PG8_BAR;
        PG8_STAGE(PG8_SB(1, 0), cB + kstep, voffB); PG8_STAGE(PG8_SA(1, 0), cA + kstep, voffA); PG8_STAGE(PG8_SB(1, 1), cB + hstep + kstep, voffB);
        PG8_WAIT_V(6); PG8_BAR;
    } else {
        PG8_STAGE(PG8_SB(0, 0), cB, voffB); PG8_STAGE(PG8_SA(0, 0), cA, voffA); PG8_STAGE(PG8_SB(0, 1), cB + hstep, voffB); PG8_STAGE(PG8_SA(0, 1), cA + hstep, voffA);
        if (wr == 1) PG8_BAR;
        PG8_WAIT_V(4); PG8_BAR;
        PG8_STAGE(PG8_SB(1, 0), cB + kstep, voffB); PG8_STAGE(PG8_SA(1, 0), cA + kstep, voffA); PG8_STAGE(PG8_SB(1, 1), cB + hstep + kstep, voffB);
        PG8_WAIT_V(6); PG8_BAR;
    }
    for (;;) {
        const bool has_next = S.next(ui + 1, nxt);
        const char* nA = has_next ? (const char*)g.A + (size_t)nxt.pm * tstep : cA; const char* nB = has_next ? (const char*)g.Bt + (size_t)nxt.pn * tstep : cB;
        for (int t = 0; t < nt; t += 2) {
            const bool last = (t == nt - 2);
            const char* a1 = cA + (size_t)(t + 1) * kstep;
            const char* a2 = last ? nA : cA + (size_t)(t + 2) * kstep; const char* b2 = last ? nB : cB + (size_t)(t + 2) * kstep;
            const char* a3 = a2 + kstep; const char* b3 = b2 + kstep;
            if (last && has_next) S.a_ready(nxt);
            if constexpr (SP2) {
            PG8_LDB(B0, 0, 0); PG8_LDB(B1, 0, 1); PG8_SCHED; PG8_LDA(At, 0, 0); PG8_STAGE(PG8_SA(1, 1), a1 + hstep, voffA);
            PG8_WAIT_V(8); PG8_WAIT_L(0); PG8_BAR; PG8_MMA(0, 0, At, B0); PG8_MMA(0, 1, At, B1); PG8_BAR; PG8_SCHED;
            PG8_LDA(At, 0, 1); PG8_STAGE(PG8_SB(0, 0), b2, voffB); PG8_STAGE(PG8_SB(0, 1), b2 + hstep, voffB); PG8_STAGE(PG8_SA(0, 0), a2, voffA);
            PG8_WAIT_V(8); PG8_WAIT_L(0); PG8_BAR; PG8_MMA(1, 0, At, B0); PG8_MMA(1, 1, At, B1); PG8_BAR; PG8_SCHED;
            PG8_LDB(B0, 1, 0); PG8_LDB(B1, 1, 1); PG8_SCHED; PG8_LDA(At, 1, 0); PG8_STAGE(PG8_SA(0, 1), a2 + hstep, voffA);
            PG8_WAIT_V(8); PG8_WAIT_L(0); PG8_BAR; PG8_MMA(0, 0, At, B0); PG8_MMA(0, 1, At, B1); PG8_BAR; PG8_SCHED;
            PG8_LDA(At, 1, 1); PG8_STAGE(PG8_SB(1, 0), b3, voffB); PG8_STAGE(PG8_SB(1, 1), b3 + hstep, voffB); PG8_STAGE(PG8_SA(1, 0), a3, voffA);
            PG8_WAIT_V(8); PG8_WAIT_L(0); PG8_BAR; PG8_MMA(1, 0, At, B0); PG8_MMA(1, 1, At, B1); PG8_BAR; PG8_SCHED;
            } else {
            PG8_LDB(B0, 0, 0); PG8_SCHED; PG8_LDA(At, 0, 0); PG8_STAGE(PG8_SA(1, 1), a1 + hstep, voffA);
            PG8_WAIT_L(8); PG8_BAR; PG8_WAIT_L(0); PG8_MMA(0, 0, At, B0); PG8_BAR; PG8_SCHED;
            PG8_LDB(B1, 0, 1); PG8_STAGE(PG8_SB(0, 0), b2, voffB);
            PG8_BAR; PG8_WAIT_L(0); PG8_MMA(0, 1, At, B1); PG8_BAR;
            PG8_LDA(At, 0, 1); PG8_STAGE(PG8_SA(0, 0), a2, voffA);
            PG8_BAR; PG8_WAIT_L(0); PG8_MMA(1, 0, At, B0); PG8_BAR; PG8_SCHED;
            PG8_STAGE(PG8_SB(0, 1), b2 + hstep, voffB);
            PG8_WAIT_V(6); PG8_BAR; PG8_MMA(1, 1, At, B1); PG8_BAR;
            PG8_LDB(B0, 1, 0); PG8_SCHED; PG8_LDA(At, 1, 0); PG8_STAGE(PG8_SA(0, 1), a2 + hstep, voffA);
            PG8_WAIT_L(8); PG8_BAR; PG8_WAIT_L(0); PG8_MMA(0, 0, At, B0); PG8_BAR; PG8_SCHED;
            PG8_LDB(B1, 1, 1); PG8_STAGE(PG8_SB(1, 0), b3, voffB);
            PG8_BAR; PG8_WAIT_L(0); PG8_MMA(0, 1, At, B1); PG8_BAR;
            PG8_LDA(At, 1, 1); PG8_STAGE(PG8_SA(1, 0), a3, voffA);
            PG8_BAR; PG8_WAIT_L(0); PG8_MMA(1, 0, At, B0); PG8_BAR; PG8_SCHED;
            PG8_STAGE(PG8_SB(1, 1), b3 + hstep, voffB);
            PG8_WAIT_V(6); PG8_BAR; PG8_MMA(1, 1, At, B1); PG8_BAR;
            }
        }
        if constexpr (ALIGN_EPI) { if (wr == 0) PG8_BAR; }
        if constexpr (!Epi::AFTER_DRAIN) { E(acc, cur, wr, wc, fr, fq); S.done(cur); }
        if (!has_next) break;
#pragma unroll
        for (int a = 0; a < 2; ++a)
#pragma unroll
            for (int b = 0; b < 2; ++b)
#pragma unroll
                for (int m = 0; m < 4; ++m)
#pragma unroll
                    for (int n = 0; n < 2; ++n) acc[a][b][m][n] = (f32x4){0.f, 0.f, 0.f, 0.f};
        cur = nxt; cA = nA; cB = nB; ++ui;
        if constexpr (ALIGN_EPI) { if (wr == 1) PG8_BAR; }
    }
    PG8_WAIT_V(0);
    if constexpr (!ALIGN_EPI) { if (wr == 0) PG8_BAR; }
    PG8_BAR;
#undef PG8_SA
#undef PG8_SB
#undef PG8_STAGE
#undef PG8_LDA
#undef PG8_LDB
#undef PG8_MMA
#undef PG8_WAIT_V
#undef PG8_WAIT_L
#undef PG8_BAR
#undef PG8_SCHED
}
}

struct Params { const float* in[32]; float* out; unsigned char* ws; };
enum { I_X = 0, I_MEM, I_LNG, I_LNB, I_WIN, I_LRE, I_LIM, I_LDT, I_BRE, I_BIM, I_CRE, I_CIM, I_SD, I_WGLU, I_BGLU, I_PE, I_CW1, I_CW2, I_NG, I_WOUT, I_L1G, I_L1B, I_WQ, I_WKV, I_WO, I_L2G, I_L2B, I_FG, I_FU, I_FD, I_L3G, I_L3B };

#define MFMA32(a, b, c) __builtin_amdgcn_mfma_f32_32x32x16_bf16((a), (b), (c), 0, 0, 0)
DI int crow(int i, int h) { return (i & 3) + 8 * (i >> 2) + 4 * h; }
template <int D> DI f32x16 qk_tile(const bf16_t* Kb, int ldk, const bf16x8 (&qf)[D / 16], int r, int h) {
    f32x16 s;
#pragma unroll
    for (int i = 0; i < 16; ++i) s[i] = 0.f;
    const bf16_t* kp = Kb + (size_t)r * ldk + 8 * h;
#pragma unroll
    for (int kk = 0; kk < D / 16; ++kk) { const bf16x8 kf = *(const bf16x8*)(kp + 16 * kk); s = MFMA32(kf, qf[kk], s); }
    return s;
}
template <int S_> DI bf16x8 pack8(const f32x16& p) {
    u32x4 w; w.x = pk2(p[8 * S_ + 0], p[8 * S_ + 1]); w.y = pk2(p[8 * S_ + 2], p[8 * S_ + 3]); w.z = pk2(p[8 * S_ + 4], p[8 * S_ + 5]); w.w = pk2(p[8 * S_ + 6], p[8 * S_ + 7]);
    return __builtin_bit_cast(bf16x8, w);
}
template <int D> DI void pv_tile(f32x16 (&o)[D / 32], const bf16_t* Vb, size_t ldv, const f32x16& p, int r, int h) {
    const bf16x8 p0 = pack8<0>(p), p1 = pack8<1>(p);
#pragma unroll
    for (int db = 0; db < D / 32; ++db) {
        const bf16_t* vp = Vb + (size_t)(32 * db + r) * ldv + 4 * h;
        const s16x4 a0 = *(const s16x4*)(vp), a1 = *(const s16x4*)(vp + 8), b0 = *(const s16x4*)(vp + 16), b1 = *(const s16x4*)(vp + 24);
        const bf16x8 va0 = __builtin_shufflevector(a0, a1, 0, 1, 2, 3, 4, 5, 6, 7), va1 = __builtin_shufflevector(b0, b1, 0, 1, 2, 3, 4, 5, 6, 7);
        o[db] = MFMA32(va0, p0, o[db]); o[db] = MFMA32(va1, p1, o[db]);
    }
}
DI void osm(const f32x16& s2, const f32x16& wgt, float& mx, float& l, f32x16& p, float& corr, const int r, const int h) {
    float tm = -INFINITY;
#pragma unroll
    for (int i = 0; i < 16; ++i) tm = wgt[i] > 0.f ? fmaxf(tm, s2[i]) : tm;
    tm = fmaxf(tm, xorl(tm, r | (h << 5), 32));
    const float mn = fmaxf(mx, tm); const float ms = (mn == -INFINITY) ? 0.f : mn;
    corr = __builtin_amdgcn_exp2f(mx - ms);
    float ps = 0.f;
#pragma unroll
    for (int i = 0; i < 16; ++i) { p[i] = wgt[i] > 0.f ? wgt[i] * __builtin_amdgcn_exp2f(s2[i] - ms) : 0.f; ps += p[i]; }
    l = l * corr + ps; mx = mn;
}
DI void osm_b(const f32x16& s2, float& mx, float& l, f32x16& p, float& corr, const int r, const int h) {
    float tm = fmaxf(fmaxf(fmaxf(s2[0], s2[1]), fmaxf(s2[2], s2[3])), fmaxf(fmaxf(s2[4], s2[5]), fmaxf(s2[6], s2[7])));
    tm = fmaxf(tm, fmaxf(fmaxf(fmaxf(s2[8], s2[9]), fmaxf(s2[10], s2[11])), fmaxf(fmaxf(s2[12], s2[13]), fmaxf(s2[14], s2[15]))));
    tm = fmaxf(tm, xorl(tm, r | (h << 5), 32));
    const float mn = fmaxf(mx, tm); const float ms = (mn == -INFINITY) ? 0.f : mn;
    corr = __builtin_amdgcn_exp2f(mx - ms);
    float ps = 0.f;
#pragma unroll
    for (int i = 0; i < 16; ++i) { p[i] = __builtin_amdgcn_exp2f(s2[i] - ms); ps += p[i]; }
    l = l * corr + ps; mx = mn;
}
template <int D> DI void load_q(bf16x8 (&qf)[D / 16], const bf16_t* qrow, int h) {
#pragma unroll
    for (int kk = 0; kk < D / 16; ++kk) qf[kk] = *(const bf16x8*)(qrow + 16 * kk + 8 * h);
}
template <int D> DI void store_o(bf16_t* orow, const f32x16 (&o)[D / 32], int h) {
#pragma unroll
    for (int db = 0; db < D / 32; ++db)
#pragma unroll
        for (int jj = 0; jj < 4; ++jj) { u32x2 w; w.x = pk2(o[db][4 * jj], o[db][4 * jj + 1]); w.y = pk2(o[db][4 * jj + 2], o[db][4 * jj + 3]); *(u32x2*)(orow + 32 * db + 8 * jj + 4 * h) = w; }
}
constexpr float L2E = 1.4426950408889634f;

template <int D> DI void load_k(bf16x8 (&kf)[D / 16], const bf16_t* Kb, int ldk, int r, int h) {
    const bf16_t* kp = Kb + (size_t)r * ldk + 8 * h;
#pragma unroll
    for (int kk = 0; kk < D / 16; ++kk) kf[kk] = *(const bf16x8*)(kp + 16 * kk);
}
template <int D> DI f32x16 qk_mm(const bf16x8 (&kf)[D / 16], const bf16x8 (&qf)[D / 16]) {
    f32x16 s;
#pragma unroll
    for (int i = 0; i < 16; ++i) s[i] = 0.f;
#pragma unroll
    for (int kk = 0; kk < D / 16; ++kk) s = MFMA32(kf[kk], qf[kk], s);
    return s;
}
template <int D> DI void load_v(s16x4 (&vf)[D / 32][4], const bf16_t* Vb, size_t ldv, int r, int h) {
#pragma unroll
    for (int db = 0; db < D / 32; ++db) { const bf16_t* vp = Vb + (size_t)(32 * db + r) * ldv + 4 * h;
        vf[db][0] = *(const s16x4*)(vp); vf[db][1] = *(const s16x4*)(vp + 8); vf[db][2] = *(const s16x4*)(vp + 16); vf[db][3] = *(const s16x4*)(vp + 24); }
}
template <int D> DI void pv_mm(f32x16 (&o)[D / 32], const s16x4 (&vf)[D / 32][4], const f32x16& p) {
    const bf16x8 p0 = pack8<0>(p), p1 = pack8<1>(p);
#pragma unroll
    for (int db = 0; db < D / 32; ++db) {
        const bf16x8 va0 = __builtin_shufflevector(vf[db][0], vf[db][1], 0, 1, 2, 3, 4, 5, 6, 7), va1 = __builtin_shufflevector(vf[db][2], vf[db][3], 0, 1, 2, 3, 4, 5, 6, 7);
        o[db] = MFMA32(va0, p0, o[db]); o[db] = MFMA32(va1, p1, o[db]); }
}
#define CPK4(dst, src) do { dst[0] = src[0]; dst[1] = src[1]; dst[2] = src[2]; dst[3] = src[3]; } while (0)

DI void sb_unit(const bf16_t* PJ, const bf16_t* VT, bf16_t* YS, int b, int head, int qt, int r, int h) {
    const int t0 = qt * 32, t = t0 + r; const size_t row = (size_t)b * SEQ + t;
    bf16x8 qf[4]; load_q<64>(qf, PJ + row * PJW + C_SBQ + head * 64, h);
    const bf16_t* Kb = PJ + (size_t)b * SEQ * PJW + C_SBK + head * 64; const bf16_t* Vb = VT + (size_t)(R_SBV + head * 64) * MTOK + (size_t)b * SEQ;
    f32x16 o[2];
#pragma unroll
    for (int i = 0; i < 16; ++i) { o[0][i] = 0.f; o[1][i] = 0.f; }
    float carry = 0.f;
    bf16x8 kA[4], kN[4]; s16x4 vA[2][4];
    load_k<64>(kA, Kb + (size_t)t0 * PJW, PJW, r, h);
#pragma unroll 1
    for (int kt = qt; kt >= 0; --kt) {
        const int k0 = kt * 32, kn = (kt > 0 ? kt - 1 : 0) * 32;
        load_v<64>(vA, Vb + k0, MTOK, r, h);
        load_k<64>(kN, Kb + (size_t)kn * PJW, PJW, r, h);
        f32x16 s = qk_mm<64>(kA, qf);
        f32x16 lfm, ls;
#pragma unroll
        for (int i = 0; i < 16; ++i) { const float z = s[i] * 0.125f; const float sp = fmaxf(z, 0.f) + __logf(1.f + __expf(-fabsf(z)));
            const bool valid = (k0 + crow(i, h)) < t; lfm[i] = valid ? -sp : 0.f; ls[i] = valid ? (z - sp) : -INFINITY; }
        float G[4], Gp[4];
#pragma unroll
        for (int j = 0; j < 4; ++j) { G[j] = (lfm[4 * j] + lfm[4 * j + 1]) + (lfm[4 * j + 2] + lfm[4 * j + 3]); Gp[j] = xorl(G[j], r | (h << 5), 32); }
        float run = carry; f32x16 w;
#pragma unroll
        for (int j = 3; j >= 0; --j) { const float gh1 = h ? G[j] : Gp[j], gh0 = h ? Gp[j] : G[j]; float a = run + (h ? 0.f : gh1);
            w[4 * j + 3] = __expf(ls[4 * j + 3] + a); a += lfm[4 * j + 3];
            w[4 * j + 2] = __expf(ls[4 * j + 2] + a); a += lfm[4 * j + 2];
            w[4 * j + 1] = __expf(ls[4 * j + 1] + a); a += lfm[4 * j + 1];
            w[4 * j + 0] = __expf(ls[4 * j + 0] + a);
            run += gh1 + gh0; }
        carry = run;
        pv_mm<64>(o, vA, w);
        CPK4(kA, kN);
        if (__all(carry < -110.f)) break;
    }
    store_o<64>(YS + row * DM + 1024 + head * 64, o, h);
}

DI void dil_unit(const bf16_t* PJ, const bf16_t* VT, bf16_t* YS, int b, int head, int qt, int r, int h) {
    const int t0 = qt * 32, t = t0 + r; const size_t row = (size_t)b * SEQ + t;
    bf16x8 qf[4]; load_q<64>(qf, PJ + row * PJW + C_DQ + head * 64, h);
    const bf16_t* Kb = PJ + (size_t)b * SEQ * PJW + C_DK + head * 64; const bf16_t* Vb = VT + (size_t)(R_DV + head * 64) * MTOK + (size_t)b * SEQ;
    f32x16 o[2];
#pragma unroll
    for (int i = 0; i < 16; ++i) { o[0][i] = 0.f; o[1][i] = 0.f; }
    float mx = -INFINITY, l = 0.f;
    bf16x8 kA[4], kN[4]; s16x4 vA[2][4];
    load_k<64>(kA, Kb, PJW, r, h);
#pragma unroll 1
    for (int kt = 0; kt <= qt; ++kt) {
        const int k0 = kt * 32, kn = (kt < qt ? kt + 1 : qt) * 32;
        load_v<64>(vA, Vb + k0, MTOK, r, h);
        load_k<64>(kN, Kb + (size_t)kn * PJW, PJW, r, h);
        f32x16 s = qk_mm<64>(kA, qf);
        f32x16 wgt, p;
#pragma unroll
        for (int i = 0; i < 16; ++i) { const int dl = t - (k0 + crow(i, h)); s[i] *= 0.125f * L2E;
            const int m = (dl <= 128 ? 1 : 0) + (((dl & 3) == 0 && dl <= 512) ? 1 : 0) + (((dl & 15) == 0) ? 1 : 0);
            wgt[i] = dl >= 0 ? (float)m : 0.f; }
        float corr; osm(s, wgt, mx, l, p, corr, r, h);
#pragma unroll
        for (int i = 0; i < 16; ++i) { o[0][i] *= corr; o[1][i] *= corr; }
        pv_mm<64>(o, vA, p);
        CPK4(kA, kN);
    }
    const float lt = l + xorl(l, r | (h << 5), 32); const float inv = lt > 0.f ? 1.f / lt : 0.f;
#pragma unroll
    for (int i = 0; i < 16; ++i) { o[0][i] *= inv; o[1][i] *= inv; }
    store_o<64>(YS + row * DM + 1536 + head * 64, o, h);
}

DI void nsa_a_unit(const bf16_t* PJ, const bf16_t* KC, const bf16_t* VCT, bf16_t* OCB, unsigned* SEL, int b, int g, int qt, int r, int h, float* wl) {
    const int t0 = qt * 32, t = t0 + r; const size_t row = (size_t)b * SEQ + t;
    float* ownl = wl + r * 33; float* spll = wl + 32 * 33 + r * 33;
#pragma unroll
    for (int m = 0; m < 16; ++m) { ownl[2 * m + h] = 0.f; spll[2 * m + h] = 0.f; }
    const bf16_t* kcb = KC + (size_t)(b * 2 + g) * 128 * 64; const bf16_t* vcb = VCT + (size_t)(b * 2 + g) * 64 * 128;
    const int ntile = (t0 + 31 >= 31) ? ((((t0 + 31 - 31) >> 4) >> 5) + 1) : 0;
#pragma unroll 1
    for (int r4 = 0; r4 < 4; ++r4) {
        const int head = g * 4 + r4;
        __builtin_amdgcn_sched_barrier(0);
        bf16x8 qf[4]; load_q<64>(qf, PJ + row * PJW + C_NQ + head * 64, h);
        float tm = -INFINITY, den = 0.f;
        bf16x8 kA[4]; s16x4 vA[2][4];
#pragma unroll 1
        for (int T = 0; T < ntile; ++T) {
            load_k<64>(kA, kcb + (size_t)(32 * T) * 64, 64, r, h);
            f32x16 s = qk_mm<64>(kA, qf); float tl = -INFINITY;
#pragma unroll
            for (int i = 0; i < 16; ++i) { const int c = 32 * T + crow(i, h); const bool valid = (c < NCMP) && (16 * c + 31 <= t); s[i] = valid ? s[i] * (0.125f * L2E) : -INFINITY; tl = fmaxf(tl, s[i]); }
            const float mn = fmaxf(tm, tl), ms = (mn == -INFINITY) ? 0.f : mn; float ps = 0.f;
#pragma unroll
            for (int i = 0; i < 16; ++i) ps += __builtin_amdgcn_exp2f(s[i] - ms);
            den = den * __builtin_amdgcn_exp2f(tm - ms) + ps; tm = mn; }
        { const float to = xorl(tm, r | (h << 5), 32), dn = xorl(den, r | (h << 5), 32); const float mn = fmaxf(tm, to), ms = (mn == -INFINITY) ? 0.f : mn;
          den = den * __builtin_amdgcn_exp2f(tm - ms) + dn * __builtin_amdgcn_exp2f(to - ms); tm = ms; }
        const float inv = 1.f / fmaxf(den, 1e-30f);
        __builtin_amdgcn_sched_barrier(0);
        f32x16 o[2];
#pragma unroll
        for (int i = 0; i < 16; ++i) { o[0][i] = 0.f; o[1][i] = 0.f; }
#pragma unroll 1
        for (int T = 0; T < ntile; ++T) { {
            load_k<64>(kA, kcb + (size_t)(32 * T) * 64, 64, r, h);
            load_v<64>(vA, vcb + 32 * T, 128, r, h);
            f32x16 s = qk_mm<64>(kA, qf);
#pragma unroll
            for (int i = 0; i < 16; ++i) { const int c = 32 * T + crow(i, h); const bool valid = (c < NCMP) && (16 * c + 31 <= t); s[i] = valid ? __builtin_amdgcn_exp2f(s[i] * (0.125f * L2E) - tm) * inv : 0.f; }
#pragma unroll
            for (int j = 0; j < 4; ++j) { const int n = 2 * (4 * T + j) + h; ownl[n] += (s[4 * j] + s[4 * j + 1]) + (s[4 * j + 2] + 0.5f * s[4 * j + 3]); spll[n] += 0.5f * s[4 * j + 3]; }
            pv_mm<64>(o, vA, s); }
            __builtin_amdgcn_sched_barrier(0);
        }
        const float g0 = sigmoidf_(bf2f(PJ[row * PJW + C_GATE + head * 3 + 0]));
#pragma unroll
        for (int i = 0; i < 16; ++i) { o[0][i] *= g0; o[1][i] *= g0; }
        store_o<64>(OCB + row * 512 + head * 64, o, h);
        __builtin_amdgcn_sched_barrier(0);
    }
    __builtin_amdgcn_wave_barrier();
    float ev[16], od[16];
#pragma unroll
    for (int m = 0; m < 16; ++m) { ev[m] = ownl[2 * m] + (m > 0 ? spll[m > 0 ? 2 * m - 1 : 0] : 0.f); od[m] = ownl[2 * m + 1] + spll[2 * m]; }
    __builtin_amdgcn_wave_barrier();
    const int cur = t >> 6;
#pragma unroll
    for (int m = 0; m < 16; ++m) {
        { const int n = 2 * m; if (n * 64 > t) ev[m] = -INFINITY; if (n == 0 || n == cur || n == cur - 1) ev[m] = INFINITY; }
        { const int n = 2 * m + 1; if (n * 64 > t) od[m] = -INFINITY; if (n == cur || n == cur - 1) od[m] = INFINITY; }
    }
    unsigned mask = 0u;
#pragma unroll 1
    for (int round = 0; round < 8; ++round) {
        float best = -INFINITY; int bi = -1;
#pragma unroll
        for (int m = 0; m < 16; ++m) { if (ev[m] > best) { best = ev[m]; bi = 2 * m; } if (od[m] > best) { best = od[m]; bi = 2 * m + 1; } }
        if (bi >= 0) mask |= 1u << bi;
#pragma unroll
        for (int m = 0; m < 16; ++m) { if (bi == 2 * m) ev[m] = -INFINITY; if (bi == 2 * m + 1) od[m] = -INFINITY; }
    }
    if (h == 0) SEL[row * 2 + g] = mask;
}

DI void nsa_b_unit(const bf16_t* PJ, const bf16_t* VT, const bf16_t* OCB, const unsigned* SEL, bf16_t* YS, int b, int head, int qt, int r, int h) {
    const int t0 = qt * 32, t = t0 + r, g = head >> 2; const size_t row = (size_t)b * SEQ + t;
    bf16x8 qf[4]; load_q<64>(qf, PJ + row * PJW + C_NQ + head * 64, h);
    const unsigned mask = SEL[row * 2 + g];
    f32x16 o[2], os[2];
#pragma unroll
    for (int i = 0; i < 16; ++i) { o[0][i] = 0.f; o[1][i] = 0.f; }
    float mx = -INFINITY, l = 0.f;
    bf16x8 kA[4], kN[4]; s16x4 vA[2][4];
    {
        unsigned um = 0u;
#pragma unroll 1
        for (int kb = 0; kb < 32; ++kb) if (__any((mask >> kb) & 1u)) um |= 1u << kb;
        unsigned long long tl = 0ull;
#pragma unroll 1
        for (int kb = 0; kb < 32; ++kb) if ((um >> kb) & 1u) tl |= 3ull << (2 * kb);
        tl &= (qt >= 63) ? ~0ull : ((1ull << (qt + 1)) - 1ull);
        const bf16_t* Kb = PJ + (size_t)b * SEQ * PJW + C_KSLC + g * 64; const bf16_t* Vb = VT + (size_t)(R_VSLC + g * 64) * MTOK + (size_t)b * SEQ;
        int kt = tl ? __builtin_ctzll(tl) : 0;
        load_k<64>(kA, Kb + (size_t)(kt * 32) * PJW, PJW, r, h);
#pragma unroll 1
        while (tl) {
            tl &= tl - 1ull; const int ktn = tl ? __builtin_ctzll(tl) : kt; const int k0 = kt * 32;
            load_v<64>(vA, Vb + k0, MTOK, r, h);
            load_k<64>(kN, Kb + (size_t)(ktn * 32) * PJW, PJW, r, h);
            f32x16 s = qk_mm<64>(kA, qf);
            const bool bit = (mask >> (kt >> 1)) & 1u;
            f32x16 wgt, p;
#pragma unroll
            for (int i = 0; i < 16; ++i) { s[i] *= 0.125f * L2E; wgt[i] = (bit && (k0 + crow(i, h)) <= t) ? 1.f : 0.f; }
            float corr; osm(s, wgt, mx, l, p, corr, r, h);
#pragma unroll
            for (int i = 0; i < 16; ++i) { o[0][i] *= corr; o[1][i] *= corr; }
            pv_mm<64>(o, vA, p);
            CPK4(kA, kN); kt = ktn;
        }
    }
    const float g1 = sigmoidf_(bf2f(PJ[row * PJW + C_GATE + head * 3 + 1])), g2 = sigmoidf_(bf2f(PJ[row * PJW + C_GATE + head * 3 + 2]));
    { const float lt = l + xorl(l, r | (h << 5), 32); const float inv = lt > 0.f ? g1 / lt : 0.f;
#pragma unroll
      for (int i = 0; i < 16; ++i) { os[0][i] = o[0][i] * inv; os[1][i] = o[1][i] * inv; o[0][i] = 0.f; o[1][i] = 0.f; } }
    mx = -INFINITY; l = 0.f;
    {
        const bf16_t* Kb = PJ + (size_t)b * SEQ * PJW + C_KWIN + g * 64; const bf16_t* Vb = VT + (size_t)(R_VWIN + g * 64) * MTOK + (size_t)b * SEQ;
        const int kt_lo = (t0 - 512) > 0 ? (t0 - 512) >> 5 : 0;
        load_k<64>(kA, Kb + (size_t)(kt_lo * 32) * PJW, PJW, r, h);
#pragma unroll 1
        for (int kt = kt_lo; kt <= qt; ++kt) {
            const int k0 = kt * 32, kn = (kt < qt ? kt + 1 : qt) * 32;
            load_v<64>(vA, Vb + k0, MTOK, r, h);
            load_k<64>(kN, Kb + (size_t)kn * PJW, PJW, r, h);
            f32x16 s = qk_mm<64>(kA, qf);
            f32x16 wgt, p;
#pragma unroll
            for (int i = 0; i < 16; ++i) { const int dl = t - (k0 + crow(i, h)); s[i] *= 0.125f * L2E; wgt[i] = (dl >= 0 && dl < 512) ? 1.f : 0.f; }
            float corr; osm(s, wgt, mx, l, p, corr, r, h);
#pragma unroll
            for (int i = 0; i < 16; ++i) { o[0][i] *= corr; o[1][i] *= corr; }
            pv_mm<64>(o, vA, p);
            CPK4(kA, kN);
        }
    }
    { const float lt = l + xorl(l, r | (h << 5), 32); const float inv = lt > 0.f ? g2 / lt : 0.f;
      const bf16_t* ocr = OCB + row * 512 + head * 64;
#pragma unroll
      for (int db = 0; db < 2; ++db)
#pragma unroll
          for (int jj = 0; jj < 4; ++jj) { const s16x4 cv = *(const s16x4*)(ocr + 32 * db + 8 * jj + 4 * h);
#pragma unroll
              for (int e = 0; e < 4; ++e) o[db][4 * jj + e] = o[db][4 * jj + e] * inv + os[db][4 * jj + e] + bf2f((bf16_t)cv[e]); } }
    store_o<64>(YS + row * DM + 512 + head * 64, o, h);
}

DI void xatt_unit(const bf16_t* QX, const bf16_t* KX, const bf16_t* KXT, bf16_t* OX, int b, int hd, int qt, int r, int h) {
    const int t = qt * 32 + r; const size_t row = (size_t)b * SEQ + t;
    bf16x8 qf[8]; load_q<128>(qf, QX + row * 512 + hd * 128, h);
    f32x16 o[4];
#pragma unroll
    for (int i = 0; i < 16; ++i) { o[0][i] = 0.f; o[1][i] = 0.f; o[2][i] = 0.f; o[3][i] = 0.f; }
    float mx = -INFINITY, l = 0.f;
    const float sc = 0.08838834764831845f * L2E;
    const bf16_t* Kb = KX + (size_t)b * MEMLEN * 1024 + hd * 128; const bf16_t* Vb = KXT + (size_t)(512 + hd * 128) * 2048 + (size_t)b * MEMLEN;
    bf16x8 kA[8]; s16x4 vA[4][4];
    load_k<128>(kA, Kb, 1024, r, h);
#pragma unroll 1
    for (int kt = 0; kt < MEMLEN / 32; ++kt) {
        const int k0 = kt * 32, kn = (kt < MEMLEN / 32 - 1 ? kt + 1 : kt) * 32;
        load_v<128>(vA, Vb + k0, 2048, r, h);
        f32x16 s = qk_mm<128>(kA, qf);
        load_k<128>(kA, Kb + (size_t)kn * 1024, 1024, r, h);
        f32x16 p, wgt;
#pragma unroll
        for (int i = 0; i < 16; ++i) { s[i] *= sc; wgt[i] = 1.f; }
        float corr; osm(s, wgt, mx, l, p, corr, r, h);
#pragma unroll
        for (int i = 0; i < 16; ++i) { o[0][i] *= corr; o[1][i] *= corr; o[2][i] *= corr; o[3][i] *= corr; }
        pv_mm<128>(o, vA, p);
    }
    const float lt = l + xorl(l, r | (h << 5), 32); const float inv = 1.f / lt;
#pragma unroll
    for (int i = 0; i < 16; ++i) { o[0][i] *= inv; o[1][i] *= inv; o[2][i] *= inv; o[3][i] *= inv; }
    store_o<128>(OX + row * 512 + hd * 128, o, h);
}

constexpr int KP = 72, VP = 68, ABUF = 64 * KP + 64 * VP;
constexpr int AFLAG = 2 * ABUF;
DI f32x16 qk_lds(const bf16_t* Kt, int st, const bf16x8 (&qf)[4], int r, int h) {
    f32x16 s;
#pragma unroll
    for (int i = 0; i < 16; ++i) s[i] = 0.f;
    const bf16_t* kp = Kt + (32 * st + r) * KP + 8 * h;
    bf16x8 kf[4];
#pragma unroll
    for (int kk = 0; kk < 4; ++kk) kf[kk] = *(const bf16x8*)(kp + 16 * kk);
    __builtin_amdgcn_s_setprio(1);
#pragma unroll
    for (int kk = 0; kk < 4; ++kk) s = MFMA32(kf[kk], qf[kk], s);
    __builtin_amdgcn_s_setprio(0);
    return s;
}
DI void pv_lds(f32x16 (&o)[2], const bf16_t* Vt, int st, const f32x16& p, int r, int h) {
    const bf16x8 p0 = pack8<0>(p), p1 = pack8<1>(p);
#pragma unroll
    for (int db = 0; db < 2; ++db) { const bf16_t* vp = Vt + (32 * db + r) * VP + 32 * st + 4 * h;
        const s16x4 a0 = *(const s16x4*)(vp), a1 = *(const s16x4*)(vp + 8), b0 = *(const s16x4*)(vp + 16), b1 = *(const s16x4*)(vp + 24);
        const bf16x8 va0 = __builtin_shufflevector(a0, a1, 0, 1, 2, 3, 4, 5, 6, 7), va1 = __builtin_shufflevector(b0, b1, 0, 1, 2, 3, 4, 5, 6, 7);
        __builtin_amdgcn_s_setprio(1); o[db] = MFMA32(va0, p0, o[db]); o[db] = MFMA32(va1, p1, o[db]); __builtin_amdgcn_s_setprio(0); }
}
enum { AM_DIL = 0, AM_SB = 1, AM_SEL = 2, AM_WIN = 3 };
template <int MODE> DI void attn_block(const bf16_t* Kb, const bf16_t* Vb, bf16_t* lds, const bf16x8 (&qf)[4], const int qb, const int t0, const int t, const unsigned mask,
                                       f32x16 (&o)[2], float& mx, float& l, const int wave, const int r, const int h, const int tid) {
    volatile unsigned* flags = (volatile unsigned*)(lds + AFLAG);
    const int srow = tid >> 3, sc = tid & 7;
    const bf16_t* kg = Kb + (size_t)srow * PJW + sc * 8; const bf16_t* vg = Vb + (size_t)srow * MTOK + sc * 8;
    const int jtop = 4 * qb + 3;
    unsigned tl = 0u;
    if (MODE == AM_SEL) {
        unsigned um = 0u;
#pragma unroll 1
        for (int kb = 0; kb <= jtop; ++kb) if (__any((mask >> kb) & 1u)) um |= 1u << kb;
        if ((tid & 63) == 0) flags[8 + wave] = um;
        __syncthreads();
#pragma unroll
        for (int w = 0; w < 8; ++w) tl |= flags[8 + w];
        tl = __builtin_amdgcn_readfirstlane(tl);
    }
    int j = (MODE == AM_DIL) ? 0 : (MODE == AM_SB) ? jtop : (MODE == AM_WIN) ? (4 * qb - 8 > 0 ? 4 * qb - 8 : 0) : (tl ? __builtin_ctz(tl) : 0);
    bool have = (MODE == AM_SEL) ? (tl != 0u) : true;
    if (MODE == AM_SEL) tl &= tl - 1u;
    u32x4 kreg, vreg;
    if (have) { kreg = *(const u32x4*)(kg + (size_t)(64 * j) * PJW); vreg = *(const u32x4*)(vg + 64 * j); }
    float carry = 0.f; bool wact = true; int it = 0;
#pragma unroll 1
    while (have) {
        bf16_t* B = lds + (it & 1) * ABUF;
        *(u32x4*)(B + srow * KP + sc * 8) = kreg;
        { u32x2* vp = (u32x2*)(B + 64 * KP + srow * VP + sc * 8); u32x2 v0, v1; v0.x = vreg.x; v0.y = vreg.y; v1.x = vreg.z; v1.y = vreg.w; vp[0] = v0; vp[1] = v1; }
        if (MODE == AM_SB) { if ((tid & 63) == 0) flags[(it & 1) * 8 + wave] = wact ? 1u : 0u; }
        __syncthreads();
        if (MODE == AM_SB) { unsigned any = 0u;
#pragma unroll
            for (int w = 0; w < 8; ++w) any |= flags[(it & 1) * 8 + w];
            if (!__builtin_amdgcn_readfirstlane(any)) break; }
        int jn = j; bool have_n;
        if (MODE == AM_DIL || MODE == AM_WIN) { jn = j + 1; have_n = jn <= jtop; }
        else if (MODE == AM_SB) { jn = j - 1; have_n = jn >= 0; }
        else { have_n = (tl != 0u); if (have_n) { jn = __builtin_ctz(tl); tl &= tl - 1u; } }
        if (have_n) { kreg = *(const u32x4*)(kg + (size_t)(64 * jn) * PJW); vreg = *(const u32x4*)(vg + 64 * jn); }
        const bf16_t* Kt = B; const bf16_t* Vt = B + 64 * KP;
#pragma unroll
        for (int sti = 0; sti < 2; ++sti) {
            const int st = (MODE == AM_SB) ? 1 - sti : sti; const int k0 = 64 * j + 32 * st;
            bool need = k0 <= t0 + 31;
            if (MODE == AM_SB) need = need && wact;
            if (MODE == AM_WIN) need = need && (k0 + 31 >= t0 - 511);
            const bool bit = (MODE == AM_SEL) ? ((mask >> j) & 1u) : true;
            if (MODE == AM_SEL) need = need && __any(bit ? 1 : 0);
            if (need) {
                f32x16 s = qk_lds(Kt, st, qf, r, h);
                if (MODE == AM_SB) {
                    f32x16 lfm, ls;
#pragma unroll
                    for (int i = 0; i < 16; ++i) { const float z = s[i] * 0.125f; const float sp = fmaxf(z, 0.f) + __logf(1.f + __expf(-fabsf(z)));
                        const bool valid = (k0 + crow(i, h)) < t; lfm[i] = valid ? -sp : 0.f; ls[i] = valid ? (z - sp) : -INFINITY; }
                    float G[4], Gp[4];
#pragma unroll
                    for (int jj = 0; jj < 4; ++jj) { G[jj] = (lfm[4 * jj] + lfm[4 * jj + 1]) + (lfm[4 * jj + 2] + lfm[4 * jj + 3]); Gp[jj] = xorl(G[jj], r | (h << 5), 32); }
                    float run = carry; f32x16 w;
#pragma unroll
                    for (int jj = 3; jj >= 0; --jj) { const float gh1 = h ? G[jj] : Gp[jj], gh0 = h ? Gp[jj] : G[jj]; float a = run + (h ? 0.f : gh1);
                        w[4 * jj + 3] = __expf(ls[4 * jj + 3] + a); a += lfm[4 * jj + 3];
                        w[4 * jj + 2] = __expf(ls[4 * jj + 2] + a); a += lfm[4 * jj + 2];
                        w[4 * jj + 1] = __expf(ls[4 * jj + 1] + a); a += lfm[4 * jj + 1];
                        w[4 * jj + 0] = __expf(ls[4 * jj + 0] + a);
                        run += gh1 + gh0; }
                    carry = run;
                    pv_lds(o, Vt, st, w, r, h);
                    wact = !__all(carry < -110.f);
                } else {
                    f32x16 p; float corr;
                    if (MODE == AM_DIL) {
                        const int base = t - k0 - 4 * h; const int dmin = t0 - (k0 + 31), dmax = t0 + 31 - k0;
                        if (dmin > 512) {
#pragma unroll
                            for (int i = 0; i < 16; ++i) { const int dl = base - ((i & 3) + 8 * (i >> 2)); s[i] = ((dl & 15) == 0) ? s[i] * (0.125f * L2E) : -INFINITY; }
                        } else if (dmin > 128 && dmax <= 512) {
#pragma unroll
                            for (int i = 0; i < 16; ++i) { const int dl = base - ((i & 3) + 8 * (i >> 2)); s[i] = ((dl & 3) == 0) ? fmaf(s[i], 0.125f * L2E, ((dl & 15) == 0) ? 1.f : 0.f) : -INFINITY; }
                        } else if (dmin >= 0 && dmax <= 128) {
#pragma unroll
                            for (int i = 0; i < 16; ++i) { const int dl = base - ((i & 3) + 8 * (i >> 2)); s[i] = fmaf(s[i], 0.125f * L2E, ((dl & 15) == 0) ? 1.5849625007f : (((dl & 3) == 0) ? 1.f : 0.f)); }
                        } else {
#pragma unroll
                            for (int i = 0; i < 16; ++i) { const int dl = base - ((i & 3) + 8 * (i >> 2));
                                const int m = (dl <= 128 ? 1 : 0) + (((dl & 3) == 0 && dl <= 512) ? 1 : 0) + (((dl & 15) == 0) ? 1 : 0);
                                const float lm = m >= 3 ? 1.5849625007f : (m == 2 ? 1.f : 0.f);
                                s[i] = (dl >= 0 && m > 0) ? fmaf(s[i], 0.125f * L2E, lm) : -INFINITY; }
                        }
                        osm_b(s, mx, l, p, corr, r, h);
                    } else {
                        const int base = t - k0 - 4 * h;
#pragma unroll
                        for (int i = 0; i < 16; ++i) { const int dl = base - ((i & 3) + 8 * (i >> 2));
                            const bool valid = (MODE == AM_WIN) ? ((unsigned)dl < 512u) : (bit && dl >= 0);
                            s[i] = valid ? s[i] * (0.125f * L2E) : -INFINITY; }
                        osm_b(s, mx, l, p, corr, r, h);
                    }
                    if (!__all(corr == 1.f)) {
#pragma unroll
                        for (int i = 0; i < 16; ++i) { o[0][i] *= corr; o[1][i] *= corr; } }
                    pv_lds(o, Vt, st, p, r, h);
                }
            }
        }
        j = jn; have = have_n; ++it;
    }
    __syncthreads();
}

constexpr int XKP = 136, XVP = 68, XBUF = 64 * XKP + 128 * XVP;
DI void xatt_block(const bf16_t* QX, const bf16_t* KX, const bf16_t* KXT, bf16_t* OX, bf16_t* lds, int b, int hd, int qb, int wave, int r, int h, int tid) {
    const int t = qb * 256 + wave * 32 + r; const size_t row = (size_t)b * SEQ + t;
    bf16x8 qf[8]; load_q<128>(qf, QX + row * 512 + hd * 128, h);
    f32x16 o[4];
#pragma unroll
    for (int i = 0; i < 16; ++i) { o[0][i] = 0.f; o[1][i] = 0.f; o[2][i] = 0.f; o[3][i] = 0.f; }
    float mx = -INFINITY, l = 0.f;
    const float sc_ = 0.08838834764831845f * L2E;
    const int srow = tid >> 3, sc = tid & 7;
    const bf16_t* kg = KX + ((size_t)b * MEMLEN + srow) * 1024 + hd * 128 + sc * 8; const bf16_t* vg = KXT + (size_t)(512 + hd * 128 + srow) * 2048 + (size_t)b * MEMLEN + sc * 8;
    u32x4 k0r, k1r, v0r, v1r;
    k0r = *(const u32x4*)(kg); k1r = *(const u32x4*)(kg + 64); v0r = *(const u32x4*)(vg); v1r = *(const u32x4*)(vg + (size_t)64 * 2048);
#pragma unroll 1
    for (int j = 0; j < 4; ++j) {
        bf16_t* B = lds + (j & 1) * XBUF;
        *(u32x4*)(B + srow * XKP + sc * 8) = k0r; *(u32x4*)(B + srow * XKP + sc * 8 + 64) = k1r;
        { u32x2* vp = (u32x2*)(B + 64 * XKP + srow * XVP + sc * 8); u32x2 a, c; a.x = v0r.x; a.y = v0r.y; c.x = v0r.z; c.y = v0r.w; vp[0] = a; vp[1] = c; }
        { u32x2* vp = (u32x2*)(B + 64 * XKP + (srow + 64) * XVP + sc * 8); u32x2 a, c; a.x = v1r.x; a.y = v1r.y; c.x = v1r.z; c.y = v1r.w; vp[0] = a; vp[1] = c; }
        __syncthreads();
        if (j < 3) { const bf16_t* kn = kg + (size_t)(64 * (j + 1)) * 1024; const bf16_t* vn = vg + 64 * (j + 1);
            k0r = *(const u32x4*)(kn); k1r = *(const u32x4*)(kn + 64); v0r = *(const u32x4*)(vn); v1r = *(const u32x4*)(vn + (size_t)64 * 2048); }
        const bf16_t* Kt = B; const bf16_t* Vt = B + 64 * XKP;
#pragma unroll
        for (int st = 0; st < 2; ++st) {
            f32x16 s;
#pragma unroll
            for (int i = 0; i < 16; ++i) s[i] = 0.f;
            const bf16_t* kp = Kt + (32 * st + r) * XKP + 8 * h;
#pragma unroll
            for (int kk = 0; kk < 8; ++kk) { const bf16x8 kf = *(const bf16x8*)(kp + 16 * kk); s = MFMA32(kf, qf[kk], s); }
            f32x16 p;
#pragma unroll
            for (int i = 0; i < 16; ++i) s[i] *= sc_;
            float corr; osm_b(s, mx, l, p, corr, r, h);
            if (!__all(corr == 1.f)) {
#pragma unroll
                for (int i = 0; i < 16; ++i) { o[0][i] *= corr; o[1][i] *= corr; o[2][i] *= corr; o[3][i] *= corr; } }
            const bf16x8 p0 = pack8<0>(p), p1 = pack8<1>(p);
#pragma unroll
            for (int db = 0; db < 4; ++db) { const bf16_t* vp = Vt + (32 * db + r) * XVP + 32 * st + 4 * h;
                const s16x4 a0 = *(const s16x4*)(vp), a1 = *(const s16x4*)(vp + 8), b0 = *(const s16x4*)(vp + 16), b1 = *(const s16x4*)(vp + 24);
                const bf16x8 va0 = __builtin_shufflevector(a0, a1, 0, 1, 2, 3, 4, 5, 6, 7), va1 = __builtin_shufflevector(b0, b1, 0, 1, 2, 3, 4, 5, 6, 7);
                o[db] = MFMA32(va0, p0, o[db]); o[db] = MFMA32(va1, p1, o[db]); }
        }
    }
    __syncthreads();
    const float lt = l + xorl(l, r | (h << 5), 32); const float inv = 1.f / lt;
#pragma unroll
    for (int i = 0; i < 16; ++i) { o[0][i] *= inv; o[1][i] *= inv; o[2][i] *= inv; o[3][i] *= inv; }
    store_o<128>(OX + row * 512 + hd * 128, o, h);
}

DI void conv_tile(const float* W, int ld, int src_col0, int nvalid, bf16_t* WT, int ldt, int dst_row0, int k0, float* scr, const int lane) {
    const float* src = W + (size_t)k0 * ld + src_col0 + 2 * lane;
    f32x2 tv[32];
#pragma unroll
    for (int k = 0; k < 32; ++k) tv[k] = __builtin_nontemporal_load((const f32x2*)(src + (size_t)k * ld));
    const bool ok0 = 2 * lane < nvalid, ok1 = 2 * lane + 1 < nvalid;
#pragma unroll
    for (int k = 0; k < 32; ++k) { scr[k * 129 + 2 * lane] = ok0 ? tv[k][0] : 0.f; scr[k * 129 + 2 * lane + 1] = ok1 ? tv[k][1] : 0.f; }
    __builtin_amdgcn_wave_barrier();
    const int kg = lane & 3;
#pragma unroll
    for (int ps = 0; ps < 8; ++ps) { const int n2 = (lane >> 2) + 16 * ps; const float* s = scr + (kg * 8) * 129 + n2;
      u32x4 o; o.x = pk2(s[0], s[129]); o.y = pk2(s[2 * 129], s[3 * 129]); o.z = pk2(s[4 * 129], s[5 * 129]); o.w = pk2(s[6 * 129], s[7 * 129]);
      *(u32x4*)(WT + (size_t)(dst_row0 + n2) * ldt + k0 + kg * 8) = o; }
    __builtin_amdgcn_wave_barrier();
}
DI void wconv_phase(const Params& p, unsigned char* ws, int L, float* wscr, const int lane, const int part, const int w0, const int nw, const int lo, const int hi) {
    constexpr int T0 = 60 * 32, T1 = T0 + 20 * 32, T2 = T1 + 32 * 32, T3 = T2 + 8 * 32, T4 = T3 + 16 * 32, T5 = T4 + 32 * 8, T6 = T5 + 176 * 32, T7 = T6 + 32 * 88, T8 = T7 + 8 * 8, T9 = T8 + 4 * 32;
    const int nit = part == 1 ? (T6 - T5) : part == 2 ? (T7 - T6) : (T5 + (T9 - T7));
    const int nend = hi < nit ? hi : nit;
    for (int it0 = lo + w0; it0 < nend; it0 += nw) {
        const int it = part == 1 ? (it0 + T5) : part == 2 ? (it0 + T6) : (it0 < T5 ? it0 : it0 + (T7 - T5));
        const float* W; int ld, col0, nvalid = 128, j, kt, ldt; bf16_t* WT;
        if (it < T0) { const int x = it; j = 2 * (x / (2 * 32)); kt = x % (2 * 32); W = p.in[I_WIN] + (size_t)L * DM * INW; ld = INW; WT = (bf16_t*)(ws + WS_WIN); ldt = DM;
            if (j < 8) col0 = 64 * j; else if (j < 16) col0 = 512 + 64 * (j - 8); else if (j < 18) col0 = 1024 + 64 * (j - 16); else if (j < 20) col0 = 1152 + 64 * (j - 18);
            else if (j < 22) col0 = 1280 + 64 * (j - 20); else if (j < 24) col0 = 1536 + 64 * (j - 22); else if (j < 32) col0 = 1816 + 64 * (j - 24); else if (j < 40) col0 = 2328 + 64 * (j - 32);
            else if (j < 48) col0 = 3352 + 64 * (j - 40); else if (j < 56) col0 = 3864 + 64 * (j - 48); else if (j == 56) { col0 = 1792; nvalid = 24; } else { col0 = 0; nvalid = 0; } }
        else if (it < T1) { const int x = it - T0; j = 2 * (x / (2 * 32)); kt = x % (2 * 32); W = p.in[I_WIN] + (size_t)L * DM * INW; ld = INW; WT = (bf16_t*)(ws + WS_WINV); ldt = DM;
            if (j < 2) col0 = 1408 + 64 * j; else if (j < 4) col0 = 1664 + 64 * (j - 2); else if (j < 12) col0 = 2840 + 64 * (j - 4); else col0 = 4376 + 64 * (j - 12); }
        else if (it < T2) { const int x = it - T1; j = 2 * (x / (2 * 32)); kt = x % (2 * 32); W = p.in[I_WOUT] + (size_t)L * DM * DM; ld = DM; WT = (bf16_t*)(ws + WS_WOUT); ldt = DM; col0 = 64 * j; }
        else if (it < T3) { const int x = it - T2; j = 2 * (x / (2 * 32)); kt = x % (2 * 32); W = p.in[I_WQ] + (size_t)L * DM * 512; ld = 512; WT = (bf16_t*)(ws + WS_WQ); ldt = DM; col0 = 64 * j; }
        else if (it < T4) { const int x = it - T3; j = 2 * (x / (2 * 32)); kt = x % (2 * 32); W = p.in[I_WKV] + (size_t)L * DM * 1024; ld = 1024; WT = (bf16_t*)(ws + WS_WKV); ldt = DM; col0 = 64 * j; }
        else if (it < T5) { const int x = it - T4; j = 2 * (x / (2 * 8)); kt = x % (2 * 8); W = p.in[I_WO] + (size_t)L * 512 * DM; ld = DM; WT = (bf16_t*)(ws + WS_WO); ldt = 512; col0 = 64 * j; }
        else if (it < T6) { const int x = it - T5; j = 2 * (x / (2 * 32)); kt = x % (2 * 32); const int pn = j >> 2, q = j & 3; W = (q < 2 ? p.in[I_FG] : p.in[I_FU]) + (size_t)L * DM * FFH; ld = FFH; WT = (bf16_t*)(ws + WS_WGU); ldt = DM; col0 = 128 * pn + 64 * (q & 1); }
        else if (it < T7) { const int x = it - T6; j = 2 * (x / (2 * 88)); kt = x % (2 * 88); W = p.in[I_FD] + (size_t)L * FFH * DM; ld = DM; WT = (bf16_t*)(ws + WS_WD); ldt = FFH; col0 = 64 * j; }
        else if (it < T8) { const int x = it - T7; j = 2 * (x / (2 * 8)); kt = x % (2 * 8); W = p.in[I_WGLU] + (size_t)L * 512 * 512; ld = 512; WT = (bf16_t*)(ws + WS_WGLU); ldt = 512; col0 = 64 * j; }
        else { const int x = it - T8; j = 2 * (x / (2 * 32)); kt = x % (2 * 32); W = p.in[I_CW1] + ((size_t)L * 2 + (j >> 1)) * DM * 128; ld = 128; WT = (bf16_t*)(ws + WS_WC1); ldt = DM; col0 = 64 * (j & 1); }
        conv_tile(W, ld, col0, nvalid, WT, ldt, 64 * j, 32 * kt, wscr, lane);
    }
}
DI void ln_row(const float* src, const float* g, const float* bsh, float* dstf, bf16_t* dstb, float* dsto, int lane) {
    f32x4 v[8]; float s = 0.f;
#pragma unroll
    for (int j = 0; j < 8; ++j) { v[j] = *(const f32x4*)(src + 256 * j + 4 * lane); s += (v[j][0] + v[j][1]) + (v[j][2] + v[j][3]); }
    const float mean = wave_sum(s, lane) * (1.f / DM); float s2 = 0.f;
#pragma unroll
    for (int j = 0; j < 8; ++j) { v[j] = v[j] - mean; s2 += (v[j][0] * v[j][0] + v[j][1] * v[j][1]) + (v[j][2] * v[j][2] + v[j][3] * v[j][3]); }
    const float rstd = 1.f / sqrtf(wave_sum(s2, lane) * (1.f / DM) + LN_EPS);
#pragma unroll
    for (int j = 0; j < 8; ++j) { const f32x4 gg = *(const f32x4*)(g + 256 * j + 4 * lane), bb = *(const f32x4*)(bsh + 256 * j + 4 * lane);
        f32x4 y = v[j] * rstd * gg + bb;
        if (dstf) *(f32x4*)(dstf + 256 * j + 4 * lane) = y;
        if (dsto) *(f32x4*)(dsto + 256 * j + 4 * lane) = y;
        u32x2 w; w.x = pk2(y[0], y[1]); w.y = pk2(y[2], y[3]); *(u32x2*)(dstb + 256 * j + 4 * lane) = w; }
}
template <int NR> DI void ln_rows(const float* src, size_t rstride, const float* g, const float* bsh, bf16_t* dstb, float* dsto, int lane) {
    f32x4 v[NR][8]; float s[NR], s2[NR];
#pragma unroll
    for (int q = 0; q < NR; ++q)
#pragma unroll
        for (int j = 0; j < 8; ++j) v[q][j] = __builtin_nontemporal_load((const f32x4*)(src + q * rstride + 256 * j + 4 * lane));
#pragma unroll
    for (int q = 0; q < NR; ++q) { s[q] = 0.f;
#pragma unroll
        for (int j = 0; j < 8; ++j) s[q] += (v[q][j][0] + v[q][j][1]) + (v[q][j][2] + v[q][j][3]); }
#pragma unroll
    for (int o = 1; o < 64; o <<= 1)
#pragma unroll
        for (int q = 0; q < NR; ++q) s[q] += xorl(s[q], lane, o);
#pragma unroll
    for (int q = 0; q < NR; ++q) { const float mean = s[q] * (1.f / DM); s2[q] = 0.f;
#pragma unroll
        for (int j = 0; j < 8; ++j) { v[q][j] = v[q][j] - mean; s2[q] += (v[q][j][0] * v[q][j][0] + v[q][j][1] * v[q][j][1]) + (v[q][j][2] * v[q][j][2] + v[q][j][3] * v[q][j][3]); } }
#pragma unroll
    for (int o = 1; o < 64; o <<= 1)
#pragma unroll
        for (int q = 0; q < NR; ++q) s2[q] += xorl(s2[q], lane, o);
#pragma unroll
    for (int j = 0; j < 8; ++j) { const f32x4 gg = *(const f32x4*)(g + 256 * j + 4 * lane), bb = *(const f32x4*)(bsh + 256 * j + 4 * lane);
#pragma unroll
        for (int q = 0; q < NR; ++q) { const float rstd = 1.f / sqrtf(s2[q] * (1.f / DM) + LN_EPS); const f32x4 y = v[q][j] * rstd * gg + bb;
            if (dsto) *(f32x4*)(dsto + q * rstride + 256 * j + 4 * lane) = y;
            u32x2 w; w.x = pk2(y[0], y[1]); w.y = pk2(y[2], y[3]); *(u32x2*)(dstb + q * rstride + 256 * j + 4 * lane) = w; } }
}

template <int NR> DI void ln_rows_b(const bf16_t* src, size_t rstride, const float* g, const float* bsh, bf16_t* dstb, float* dsto, int lane) {
    bf16x8 raw[NR][4]; float s[NR], s2[NR];
#pragma unroll
    for (int q = 0; q < NR; ++q)
#pragma unroll
        for (int j = 0; j < 4; ++j) raw[q][j] = *(const bf16x8*)(src + q * rstride + 512 * j + 8 * lane);
#pragma unroll
    for (int q = 0; q < NR; ++q) { s[q] = 0.f;
#pragma unroll
        for (int j = 0; j < 4; ++j)
#pragma unroll
            for (int e = 0; e < 8; ++e) s[q] += bf2f((bf16_t)raw[q][j][e]); }
#pragma unroll
    for (int o = 1; o < 64; o <<= 1)
#pragma unroll
        for (int q = 0; q < NR; ++q) s[q] += xorl(s[q], lane, o);
#pragma unroll
    for (int q = 0; q < NR; ++q) { const float mean = s[q] * (1.f / DM); s[q] = mean; s2[q] = 0.f;
#pragma unroll
        for (int j = 0; j < 4; ++j)
#pragma unroll
            for (int e = 0; e < 8; ++e) { const float d = bf2f((bf16_t)raw[q][j][e]) - mean; s2[q] += d * d; } }
#pragma unroll
    for (int o = 1; o < 64; o <<= 1)
#pragma unroll
        for (int q = 0; q < NR; ++q) s2[q] += xorl(s2[q], lane, o);
#pragma unroll
    for (int j = 0; j < 4; ++j) { const float* gp = g + 512 * j + 8 * lane; const float* bp = bsh + 512 * j + 8 * lane;
        const f32x4 g0 = *(const f32x4*)gp, g1 = *(const f32x4*)(gp + 4), b0 = *(const f32x4*)bp, b1 = *(const f32x4*)(bp + 4);
#pragma unroll
        for (int q = 0; q < NR; ++q) { const float rstd = 1.f / sqrtf(s2[q] * (1.f / DM) + LN_EPS), mean = s[q]; f32x4 y0, y1;
#pragma unroll
            for (int e = 0; e < 4; ++e) { y0[e] = (bf2f((bf16_t)raw[q][j][e]) - mean) * rstd * g0[e] + b0[e]; y1[e] = (bf2f((bf16_t)raw[q][j][4 + e]) - mean) * rstd * g1[e] + b1[e]; }
            if (dsto) { __builtin_nontemporal_store(y0, (f32x4*)(dsto + q * rstride + 512 * j + 8 * lane)); __builtin_nontemporal_store(y1, (f32x4*)(dsto + q * rstride + 512 * j + 8 * lane + 4)); }
            u32x4 w; w.x = pk2(y0[0], y0[1]); w.y = pk2(y0[2], y0[3]); w.z = pk2(y1[0], y1[1]); w.w = pk2(y1[2], y1[3]);
            if (dstb) *(u32x4*)(dstb + q * rstride + 512 * j + 8 * lane) = w; } }
}

#define XB_TMO      128
#define XB_XCNT(j)  (256  + 64 * (j))
#define XB_XSUB(j)  (1280 + 64 * (j))
#define XB_XGEN(j)  (2304 + 64 * (j))
#define XB_TOP      3328
#define XB_TOPGEN   3392
#define XCD_BAR_WORDS 3456
#define XB_SPIN_CAP (1u << 18)

__device__ __forceinline__ unsigned xb_ld(unsigned* p)              { return __hip_atomic_load(p, __ATOMIC_RELAXED, __HIP_MEMORY_SCOPE_AGENT); }
__device__ __forceinline__ unsigned xb_add(unsigned* p, unsigned v) { return __hip_atomic_fetch_add(p, v, __ATOMIC_RELAXED, __HIP_MEMORY_SCOPE_AGENT); }
__device__ __forceinline__ unsigned xb_xcc_id() { return (unsigned)__builtin_amdgcn_s_getreg((3 << 11) | 20) & 0xFu; }
#define XB_SPIN(cond, bar) do { unsigned _sp = 0; while (cond) { __builtin_amdgcn_s_sleep(1); \
    if ((++_sp & 255u) == 0u) { if (xb_ld(&(bar)[XB_TMO])) break; if (_sp > XB_SPIN_CAP) { atomicAdd(&(bar)[XB_TMO], 1u); break; } } } } while (0)

struct XcdBarrier {
    unsigned* bar; unsigned x;
    volatile LAS unsigned* st;
};

__device__ __forceinline__ XcdBarrier xcd_barrier_post(unsigned* bar, volatile LAS unsigned* st) {
    XcdBarrier b; b.bar = bar; b.x = xb_xcc_id(); b.st = st;
    if (threadIdx.x == 0) (void)xb_add(&bar[XB_XCNT(b.x)], 1u);
    return b;
}
__device__ __forceinline__ void xcd_barrier_complete(unsigned* bar, unsigned x, unsigned& nloc, unsigned& nx) {
    const unsigned G = gridDim.x * gridDim.y * gridDim.z;
    unsigned sum, cnt, mine, sp = 0u;
    for (;;) {
        sum = 0u; cnt = 0u; mine = 0u;
#pragma unroll
        for (unsigned j = 0; j < 16; ++j) { const unsigned c = xb_ld(&bar[XB_XCNT(j)]); sum += c; cnt += (c > 0u) ? 1u : 0u; mine = (j == x) ? c : mine; }
        if (sum == G) break;
        __builtin_amdgcn_s_sleep(1);
        if ((++sp & 255u) == 0u) { if (xb_ld(&bar[XB_TMO])) break; if (sp > XB_SPIN_CAP) { atomicAdd(&bar[XB_TMO], 1u); break; } }
    }
    nloc = mine > 0u ? mine : 1u; nx = cnt > 0u ? cnt : 1u;
}

__device__ __forceinline__ void xcd_barrier(const XcdBarrier& b) {
    asm volatile("s_waitcnt vmcnt(0)" ::: "memory");
    __syncthreads();
    if (threadIdx.x == 0) {
        unsigned* bar = b.bar;
        __builtin_amdgcn_s_waitcnt(0);
        unsigned nloc = b.st[0], nx = b.st[1];
        if (nloc == 0u) { xcd_barrier_complete(bar, b.x, nloc, nx); b.st[0] = nloc; b.st[1] = nx; }
        const unsigned old = xb_add(&bar[XB_XSUB(b.x)], 1u);
        const unsigned gen = old / nloc;
        if (old + 1u == (gen + 1u) * nloc) {
            __builtin_amdgcn_fence(__ATOMIC_RELEASE, "agent");
            asm volatile("s_waitcnt vmcnt(0)" ::: "memory");
            const unsigned og = xb_add(&bar[XB_TOP], 1u);
            const unsigned tg = og / nx;
            if (og + 1u == (tg + 1u) * nx) xb_add(&bar[XB_TOPGEN], 1u);
            else XB_SPIN(xb_ld(&bar[XB_TOPGEN]) == tg, bar);
            __builtin_amdgcn_fence(__ATOMIC_ACQUIRE, "agent");
            xb_add(&bar[XB_XGEN(b.x)], 1u);
            asm volatile("s_waitcnt vmcnt(0)" ::: "memory");
        } else {
            XB_SPIN(xb_ld(&bar[XB_XGEN(b.x)]) == gen, bar);
            __builtin_amdgcn_fence(__ATOMIC_ACQUIRE, "agent");
            asm volatile("s_waitcnt vmcnt(0)" ::: "memory");
        }
    }
    __syncthreads();
}

constexpr int GU_EARLY = 960;
#ifndef MK_REP_SUB
#define MK_REP_SUB 0
#endif
#ifndef MK_REP_MASK
#define MK_REP_MASK 0
#endif
constexpr int PH_PER_LAYER = 20, N_PHASES = PH_PER_LAYER * DEPTH;

__global__ void __launch_bounds__(512, 2) mk_fwd(Params p, int ph_lo, int ph_hi) {
    extern __shared__ __attribute__((aligned(16))) unsigned char lds_raw[];
    LAS unsigned char* lds = (LAS unsigned char*)lds_raw;
    float* scr = (float*)lds_raw;
    cg::grid_group grid = cg::this_grid();
    const int wave0 = __builtin_amdgcn_readfirstlane(threadIdx.x >> 6);
    { volatile LAS unsigned* st0 = (volatile LAS unsigned*)(lds + LDS_BYTES - 128); if (threadIdx.x < 2) st0[threadIdx.x] = 0u; __syncthreads(); }
    const XcdBarrier xbar = xcd_barrier_post((unsigned*)(p.ws + WS_BAR), (volatile LAS unsigned*)(lds + LDS_BYTES - 128));
#pragma unroll 1
    for (int ph2 = 2 * ph_lo; ph2 < 2 * ph_hi; ++ph2) {
        const int ph = ph2 >> 1;
        const int L = ph / PH_PER_LAYER, step = ph % PH_PER_LAYER;
        const int k = step <= 3 ? step : step <= 6 ? step + 13 : step - 3;
        const bool sync_after = !(step >= 3 && step <= 5);
        if ((ph2 & 1) && !((MK_REP_MASK >> k) & 1)) continue;
        int lane_; asm volatile("v_mbcnt_lo_u32_b32 %0, -1, 0\n\tv_mbcnt_hi_u32_b32 %0, -1, %0" : "=v"(lane_));
        const int tid = wave0 * 64 + lane_;
        unsigned char* ws = p.ws; asm volatile("" : "+s"(ws));
        float* scr = (float*)lds_raw;
        const int lane = tid & 63, wave = __builtin_amdgcn_readfirstlane(tid >> 6);
        const int gw = blockIdx.x * 8 + wave, NGW = gridDim.x * 8;
        const int r = lane & 31, h = lane >> 5;
        float* HF = (float*)(ws + WS_HF); bf16_t* HB = (bf16_t*)(ws + WS_HB); bf16_t* PJ = (bf16_t*)(ws + WS_PJ); bf16_t* VT = (bf16_t*)(ws + WS_VT);
        bf16_t* YS = (bf16_t*)(ws + WS_YS); bf16_t* GA = (bf16_t*)(ws + WS_GA); bf16_t* OCB = (bf16_t*)(ws + WS_OCB); float* ROPE = (float*)(ws + WS_ROPE);
        bf16_t* CMPA = (bf16_t*)(ws + WS_CMPA); bf16_t* HC = (bf16_t*)(ws + WS_HC); bf16_t* KC = (bf16_t*)(ws + WS_KC); bf16_t* VCT = (bf16_t*)(ws + WS_VCT);
        unsigned* SEL = (unsigned*)(ws + WS_SEL); f32x2* S5E = (f32x2*)(ws + WS_S5E); bf16_t* MEMB = (bf16_t*)(ws + WS_MEMB);
        bf16_t* QX = (bf16_t*)(ws + WS_QX); bf16_t* OX = (bf16_t*)(ws + WS_OX); bf16_t* KX = (bf16_t*)(ws + WS_KX); bf16_t* KXT = (bf16_t*)(ws + WS_KXT);
        {
            const int ng = (k == 1) ? 2 : (k == 10) ? 3 : (k == 3 || k == 4 || k == 8 || k == 12 || k == 14 || k == 15) ? 1 : 0;
            for (int gi = 0; gi < ng; ++gi) {
                size_t oA = 0, oB = 0, oO = 0; int gM = 0, gN = 0, gK = DM, gmode = 0, gld = 0, grot = 0;
                if (k == 1) { if (gi == 0) { oA = WS_HB; oB = WS_WIN; gM = MTOK; gN = PJW; oO = WS_PJ; gld = PJW; } else { oA = WS_WINV; oB = WS_HB; gM = VTR; gN = MTOK; oO = WS_VT; gld = MTOK; grot = 64; } }
                else if (k == 3) { oA = WS_CMPA; oB = WS_WC1; gM = 4096; gN = 256; gmode = 1; oO = WS_HC; gld = 256; }
                else if (k == 4) { oA = WS_GA; oB = WS_WGLU; gM = MTOK; gN = 512; gK = 512; gmode = 4; oO = WS_YS; gld = DM; }
                else if (k == 8) { oA = WS_YS; oB = WS_WOUT; gM = MTOK; gN = DM; gmode = 2; oO = WS_HF; gld = DM; }
                else if (k == 10) { if (gi == 0) { oA = WS_HB; oB = WS_WQ; gM = MTOK; gN = 512; oO = WS_QX; gld = 512; } else if (gi == 1) { oA = WS_MEMB; oB = WS_WKV; gM = 2048; gN = 1024; oO = WS_KX; gld = 1024; grot = 128; } else { oA = WS_WKV; oB = WS_MEMB; gM = 1024; gN = 2048; oO = WS_KXT; gld = 2048; grot = 96; } }
                else if (k == 12) { oA = WS_OX; oB = WS_WO; gM = MTOK; gN = DM; gK = 512; gmode = 2; oO = WS_HF; gld = DM; }
                else if (k == 14) { oA = WS_HB; oB = WS_WGU; gM = MTOK; gN = 2 * FFH; gmode = 3; oO = WS_ACT; gld = FFH; }
                else { oA = WS_ACT; oB = WS_WD; gM = MTOK; gN = DM; gK = FFH; gmode = 2; oO = WS_HF; gld = DM; }
                pg8::Gemm g{(const bf16_t*)(ws + oA), (const bf16_t*)(ws + oB), gM, gN, gK};
                pg8::StaticOrder S; S.init(gM, gN, (int)gridDim.x, (int)((blockIdx.x + grot) % gridDim.x));
                pg8::EpiAny E{gmode, (void*)(ws + oO), gld, (const void*)(ws + (gmode == 2 ? WS_HB : WS_GA)), (const void*)(p.in[I_BGLU] + L * 512)};
                pg8::gemm_phase<pg8::EpiAny, pg8::StaticOrder, true, true>(lds, g, S, E, tid);
                __syncthreads();
            }
        }

        if (k == 0) {
            wconv_phase(p, ws, L, scr + wave * (64 * 65), lane, 0, gw, NGW, 0, 1 << 30);
            if (L == 0) {
                for (int i = blockIdx.x * 512 + tid; i < 2048 * 32; i += gridDim.x * 512) { const int pos = i >> 5, f = i & 31;
                    const float invf = powf(10000.f, -(float)f / 32.f); float sn, cs; sincos_acc((float)pos * invf, sn, cs); ROPE[2 * i] = cs; ROPE[2 * i + 1] = sn; }
                for (int m = gw; m < MTOK / 4; m += NGW) ln_rows<4>(p.in[I_X] + (size_t)m * DM, (size_t)(MTOK / 4) * DM, p.in[I_LNG], p.in[I_LNB], HB + (size_t)m * DM, nullptr, lane);
                for (size_t i = (size_t)blockIdx.x * 512 + tid; i < (size_t)2048 * DM / 4; i += (size_t)gridDim.x * 512) { const f32x4 v = *(const f32x4*)(p.in[I_MEM] + 4 * i); u32x2 w; w.x = pk2(v[0], v[1]); w.y = pk2(v[2], v[3]); *(u32x2*)(MEMB + 4 * i) = w; }
            }
        } else if (k == 2) {
            for (int m = gw; m < MTOK; m += NGW) { const int pos = m & (SEQ - 1); bf16_t* rowp = PJ + (size_t)m * PJW;
                unsigned xa[7], xb[7]; f32x4 cs[7];
#pragma unroll
                for (int i = 0; i < 7; ++i) { const int task = lane + 64 * i, hs = task >> 4, d = (task & 15) * 2;
                    const int cb = hs < 8 ? C_NQ + 64 * hs : hs < 12 ? C_KSLC + 64 * (hs - 8) : hs < 20 ? C_DQ + 64 * (hs - 12) : C_DK + 64 * (hs - 20);
                    xa[i] = *(const unsigned*)(rowp + cb + d); xb[i] = *(const unsigned*)(rowp + cb + d + 32); cs[i] = *(const f32x4*)(ROPE + (pos * 32 + d) * 2); }
#pragma unroll
                for (int i = 0; i < 7; ++i) { const int task = lane + 64 * i, hs = task >> 4, d = (task & 15) * 2;
                    const int cb = hs < 8 ? C_NQ + 64 * hs : hs < 12 ? C_KSLC + 64 * (hs - 8) : hs < 20 ? C_DQ + 64 * (hs - 12) : C_DK + 64 * (hs - 20);
                    const float a0 = bf2f((bf16_t)(xa[i] & 0xffffu)), a1 = bf2f((bf16_t)(xa[i] >> 16)), b0 = bf2f((bf16_t)(xb[i] & 0xffffu)), b1 = bf2f((bf16_t)(xb[i] >> 16));
                    *(unsigned*)(rowp + cb + d) = pk2(a0 * cs[i][0] - b0 * cs[i][1], a1 * cs[i][2] - b1 * cs[i][3]);
                    *(unsigned*)(rowp + cb + d + 32) = pk2(b0 * cs[i][0] + a0 * cs[i][1], b1 * cs[i][2] + a1 * cs[i][3]); } }
            for (int it = gw; it < 2 * 2032; it += NGW) { const int j = it / 2032, rr = it % 2032, g = rr & 1, bi = rr >> 1, b = bi / NCMP, ci = bi % NCMP;
                const float* pe = p.in[I_PE] + ((size_t)L * 2 + j) * 32 * 64; bf16_t* dst = CMPA + ((size_t)j * 2048 + rr) * DM;
#pragma unroll
                for (int q = 0; q < 4; ++q) { const int l = (lane >> 3) + 8 * q, d0 = 8 * (lane & 7);
                    const bf16x8 v = *(const bf16x8*)(PJ + ((size_t)b * SEQ + 16 * ci + l) * PJW + C_KCMP + j * 128 + g * 64 + d0);
                    const f32x4 e0 = *(const f32x4*)(pe + l * 64 + d0), e1 = *(const f32x4*)(pe + l * 64 + d0 + 4);
                    u32x4 w; w.x = pk2(bf2f((bf16_t)v[0]) + e0[0], bf2f((bf16_t)v[1]) + e0[1]); w.y = pk2(bf2f((bf16_t)v[2]) + e0[2], bf2f((bf16_t)v[3]) + e0[3]);
                    w.z = pk2(bf2f((bf16_t)v[4]) + e1[0], bf2f((bf16_t)v[5]) + e1[1]); w.w = pk2(bf2f((bf16_t)v[6]) + e1[2], bf2f((bf16_t)v[7]) + e1[3]);
                    *(u32x4*)(dst + l * 64 + d0) = w; } }
            for (int it = gw; it < 8 * 32 * 32; it += NGW) { const int ck = it & 31, g = (it >> 5) & 31, b = it >> 10; const int pst = lane;
                const size_t gp = ((size_t)L * 32 + g) * 64 + pst;
                const float lr = fminf(p.in[I_LRE][gp], -1e-4f), li = p.in[I_LIM][gp], dt = expf(p.in[I_LDT][L * 32 + g]);
                const float mag = expf(lr * dt); float sn, cs; sincos_acc(li * dt, sn, cs); const float are = mag * cs, aim = mag * sn;
                const float den = lr * lr + li * li, zre = ((are - 1.f) * lr + aim * li) / den, zim = (aim * lr - (are - 1.f) * li) / den;
                float bbr[16], bbi[16];
#pragma unroll
                for (int c4 = 0; c4 < 4; ++c4) { const f32x4 br = *(const f32x4*)(p.in[I_BRE] + gp * 16 + 4 * c4), bi = *(const f32x4*)(p.in[I_BIM] + gp * 16 + 4 * c4);
#pragma unroll
                    for (int e = 0; e < 4; ++e) { bbr[4 * c4 + e] = zre * br[e] - zim * bi[e]; bbi[4 * c4 + e] = zre * bi[e] + zim * br[e]; } }
                float xr = 0.f, xi = 0.f;
                float* Uf = (float*)lds_raw + wave * 1024;
                { const bf16_t* upl = PJ + ((size_t)b * SEQ + ck * 64 + lane) * PJW + C_U + g * 16; const bf16x8 ua = *(const bf16x8*)upl, ub = *(const bf16x8*)(upl + 8);
                  __builtin_amdgcn_wave_barrier();
                  f32x4 w0, w1, w2, w3;
#pragma unroll
                  for (int e = 0; e < 4; ++e) { w0[e] = bf2f((bf16_t)ua[e]); w1[e] = bf2f((bf16_t)ua[4 + e]); w2[e] = bf2f((bf16_t)ub[e]); w3[e] = bf2f((bf16_t)ub[4 + e]); }
                  f32x4* ud = (f32x4*)(Uf + lane * 16); ud[0] = w0; ud[1] = w1; ud[2] = w2; ud[3] = w3;
                  __builtin_amdgcn_wave_barrier(); }
                f32x2 bbp[16];
#pragma unroll
                for (int c = 0; c < 16; ++c) { bbp[c].x = bbr[c]; bbp[c].y = bbi[c]; }
#pragma unroll 8
                for (int tt = 0; tt < 64; ++tt) { const f32x4* up = (const f32x4*)(Uf + tt * 16);
                    const f32x4 u0 = up[0], u1 = up[1], u2 = up[2], u3 = up[3]; f32x2 a0 = {0.f, 0.f}, a1 = {0.f, 0.f};
#pragma unroll
                    for (int c = 0; c < 4; ++c) { a0 += bbp[c] * u0[c]; a1 += bbp[4 + c] * u1[c]; a0 += bbp[8 + c] * u2[c]; a1 += bbp[12 + c] * u3[c]; }
                    const float bur = a0.x + a1.x, bui = a0.y + a1.y;
                    const float nr = are * xr - aim * xi + bur, ni = are * xi + aim * xr + bui; xr = nr; xi = ni; }
                f32x2 e; e.x = xr; e.y = xi; S5E[(size_t)it * 64 + pst] = e; }
        } else if (k == 4) {
            for (int it = gw; it < 2 * 2032; it += NGW) { const int j = it / 2032, rr = it % 2032, g = rr & 1, bi = rr >> 1, b = bi / NCMP, ci = bi % NCMP;
                const bf16_t* hr = HC + ((size_t)j * 2048 + rr) * 256 + j * 128; const float* w2 = p.in[I_CW2] + ((size_t)L * 2 + j) * 128 * 64;
                float acc = 0.f;
#pragma unroll 4
                for (int kk = 0; kk < 128; kk += 8) { const bf16x8 hv = *(const bf16x8*)(hr + kk);
#pragma unroll
                    for (int e = 0; e < 8; ++e) acc += bf2f((bf16_t)hv[e]) * w2[(kk + e) * 64 + lane]; }
                if (j == 0) { const int pos = 16 * ci + 31, d = lane & 31; const float cs = ROPE[(pos * 32 + d) * 2], sn = ROPE[(pos * 32 + d) * 2 + 1];
                    const float other = xorl(acc, r | (h << 5), 32); const float o = lane < 32 ? acc * cs - other * sn : acc * cs + other * sn;
                    KC[((size_t)(b * 2 + g) * 128 + ci) * 64 + lane] = f2bf(o); }
                else VCT[((size_t)(b * 2 + g) * 64 + lane) * 128 + ci] = f2bf(acc); }
        } else if (k == 5) {
            if ((wave & 1) == 0) for (int u = blockIdx.x * 4 + (wave >> 1); u < 1024; u += gridDim.x * 4) { const int qt = 63 - (u >> 4), bg = u & 15; nsa_a_unit(PJ, KC, VCT, OCB, SEL, bg >> 1, bg & 1, qt, r, h, scr + wave * (2 * 32 * 33)); }
        } else if (k == 17) {
            for (int rp = 0; rp < 1 + ((MK_REP_SUB >> 0) & 1); ++rp)
            { bf16_t* XSb = (bf16_t*)lds_raw + wave * (16 * 136);
              const bool g256 = gridDim.x == 256; const int nui = g256 ? 5 : (1024 + (int)gridDim.x - 1) / (int)gridDim.x;
              for (int ui = 0; ui < nui; ++ui) { int bu;
                if (g256) { if (blockIdx.x < 16) { if (ui > 0) break; bu = 960 + (int)blockIdx.x; } else { const int bb = (int)blockIdx.x - 16; if (ui < 4) bu = bb + 240 * ui; else { if (bb >= 48) break; bu = 976 + bb; } } }
                else { bu = (int)blockIdx.x + ui * (int)gridDim.x; if (bu >= 1024) break; }
                const int kg = bu & 3, g = (bu >> 2) & 31, b = bu >> 7, ck = kg * 8 + wave;
                const size_t gp = ((size_t)L * 32 + g) * 64 + lane;
                const float lr = fminf(p.in[I_LRE][gp], -1e-4f), li = p.in[I_LIM][gp], dt = expf(p.in[I_LDT][L * 32 + g]);
                const float mag = expf(lr * dt); float sn, cs; sincos_acc(li * dt, sn, cs); const float are = mag * cs, aim = mag * sn;
                const float den = lr * lr + li * li, zre = ((are - 1.f) * lr + aim * li) / den, zim = (aim * lr - (are - 1.f) * li) / den;
                const float magL = expf(lr * dt * 64.f); float snL, csL; sincos_acc(li * dt * 64.f, snL, csL); const float aLr = magL * csL, aLi = magL * snL;
                float bbr[16], bbi[16];
#pragma unroll
                for (int c4 = 0; c4 < 4; ++c4) { const f32x4 br = *(const f32x4*)(p.in[I_BRE] + gp * 16 + 4 * c4), bi = *(const f32x4*)(p.in[I_BIM] + gp * 16 + 4 * c4);
#pragma unroll
                    for (int e = 0; e < 4; ++e) { bbr[4 * c4 + e] = zre * br[e] - zim * bi[e]; bbi[4 * c4 + e] = zre * bi[e] + zim * br[e]; } }
                const int c = lane & 15, quad = lane >> 4;
                bf16x8 cwf[4];
#pragma unroll
                for (int kk = 0; kk < 4; ++kk) { const int kb = 32 * kk + 8 * quad; const float* src = (kb < 64 ? p.in[I_CRE] : p.in[I_CIM]) + (((size_t)L * 32 + g) * 16 + c) * 64 + (kb & 63);
                    const f32x4 c0 = *(const f32x4*)src, c1 = *(const f32x4*)(src + 4); const float sg = kb < 64 ? 1.f : -1.f;
                    u32x4 w; w.x = pk2(sg * c0[0], sg * c0[1]); w.y = pk2(sg * c0[2], sg * c0[3]); w.z = pk2(sg * c1[0], sg * c1[1]); w.w = pk2(sg * c1[2], sg * c1[3]); cwf[kk] = __builtin_bit_cast(bf16x8, w); }
                float xr = 0.f, xi = 0.f;
#pragma unroll 8
                for (int jq = 0; jq < ck; ++jq) { const f32x2 e = S5E[((size_t)(b * 32 + g) * 32 + jq) * 64 + lane]; const float nr = aLr * xr - aLi * xi + e.x, ni = aLr * xi + aLi * xr + e.y; xr = nr; xi = ni; }
                const float dsk = p.in[I_SD][((size_t)L * 32 + g) * 16 + c];
                float* Uf = (float*)(lds_raw + 8 * (16 * 136) * 2) + wave * 1024;
                { const bf16_t* upl = PJ + ((size_t)b * SEQ + ck * 64 + lane) * PJW + C_U + g * 16; const bf16x8 ua = *(const bf16x8*)upl, ub = *(const bf16x8*)(upl + 8);
                  __builtin_amdgcn_wave_barrier();
                  f32x4 w0, w1, w2, w3;
#pragma unroll
                  for (int e = 0; e < 4; ++e) { w0[e] = bf2f((bf16_t)ua[e]); w1[e] = bf2f((bf16_t)ua[4 + e]); w2[e] = bf2f((bf16_t)ub[e]); w3[e] = bf2f((bf16_t)ub[4 + e]); }
                  f32x4* ud = (f32x4*)(Uf + lane * 16); ud[0] = w0; ud[1] = w1; ud[2] = w2; ud[3] = w3;
                  __builtin_amdgcn_wave_barrier(); }
                f32x2 bbp[16];
#pragma unroll
                for (int cq = 0; cq < 16; ++cq) { bbp[cq].x = bbr[cq]; bbp[cq].y = bbi[cq]; }
                for (int sc4 = 0; sc4 < 4; ++sc4) {
#pragma unroll 8
                    for (int tt = 0; tt < 16; ++tt) { const f32x4* up = (const f32x4*)(Uf + (sc4 * 16 + tt) * 16);
                        const f32x4 u0 = up[0], u1 = up[1], u2 = up[2], u3 = up[3]; f32x2 a0 = {0.f, 0.f}, a1 = {0.f, 0.f};
#pragma unroll
                        for (int cc = 0; cc < 4; ++cc) { a0 += bbp[cc] * u0[cc]; a1 += bbp[4 + cc] * u1[cc]; a0 += bbp[8 + cc] * u2[cc]; a1 += bbp[12 + cc] * u3[cc]; }
                        const float bur = a0.x + a1.x, bui = a0.y + a1.y;
                        const float nr = are * xr - aim * xi + bur, ni = are * xi + aim * xr + bui; xr = nr; xi = ni;
                        XSb[tt * 136 + lane] = f2bf(xr); XSb[tt * 136 + 64 + lane] = f2bf(xi); }
                    __builtin_amdgcn_wave_barrier();
                    f32x4 y = {0.f, 0.f, 0.f, 0.f};
#pragma unroll
                    for (int kk = 0; kk < 4; ++kk) { const bf16x8 xa = *(const bf16x8*)(XSb + c * 136 + 32 * kk + 8 * quad);
                        y = __builtin_amdgcn_mfma_f32_16x16x32_bf16(xa, cwf[kk], y, 0, 0, 0); }
                    __builtin_amdgcn_wave_barrier();
#pragma unroll
                    for (int i = 0; i < 4; ++i) { const size_t row = (size_t)b * SEQ + ck * 64 + sc4 * 16 + 4 * quad + i; const float uv = Uf[(sc4 * 16 + 4 * quad + i) * 16 + c];
                        GA[row * 512 + g * 16 + c] = f2bf(gelu_tanh(y[i] + dsk * uv)); }
                }
              }
              __syncthreads(); }
        } else if (k == 18 || k == 19) {
            for (int rp = 0; rp < 1 + ((k == 19) ? ((MK_REP_SUB >> 1) & 1) : 0); ++rp)
            for (int u = blockIdx.x; u < 512; u += gridDim.x) { const int bh = u & 63, qb = u < 256 ? 7 - (u >> 6) : (u >> 6) - 4, b = bh >> 3, head = bh & 7;
                const int t0 = qb * 256 + wave * 32, t = t0 + r; const size_t row = (size_t)b * SEQ + t;
                bf16x8 qf[4]; load_q<64>(qf, PJ + row * PJW + (k == 18 ? C_SBQ : C_DQ) + head * 64, h);
                f32x16 o[2];
#pragma unroll
                for (int i = 0; i < 16; ++i) { o[0][i] = 0.f; o[1][i] = 0.f; }
                float mx = -INFINITY, l = 0.f;
                if (k == 18) attn_block<AM_SB>(PJ + (size_t)b * SEQ * PJW + C_SBK + head * 64, VT + (size_t)(R_SBV + head * 64) * MTOK + (size_t)b * SEQ, (bf16_t*)lds_raw, qf, qb, t0, t, 0u, o, mx, l, wave, r, h, tid);
                else { attn_block<AM_DIL>(PJ + (size_t)b * SEQ * PJW + C_DK + head * 64, VT + (size_t)(R_DV + head * 64) * MTOK + (size_t)b * SEQ, (bf16_t*)lds_raw, qf, qb, t0, t, 0u, o, mx, l, wave, r, h, tid);
                    const float lt = l + xorl(l, r | (h << 5), 32); const float inv = lt > 0.f ? 1.f / lt : 0.f;
#pragma unroll
                    for (int i = 0; i < 16; ++i) { o[0][i] *= inv; o[1][i] *= inv; } }
                store_o<64>(YS + row * DM + (k == 18 ? 1024 : 1536) + head * 64, o, h);
            }
        } else if (k == 6) {
            for (int rp = 0; rp < 1 + ((MK_REP_SUB >> 2) & 1); ++rp)
            for (int u = blockIdx.x; u < 512; u += gridDim.x) { const int bh = u & 63, qb = u < 256 ? 7 - (u >> 6) : (u >> 6) - 4, b = bh >> 3, head = bh & 7, g = head >> 2;
                const int t0 = qb * 256 + wave * 32, t = t0 + r; const size_t row = (size_t)b * SEQ + t;
                bf16x8 qf[4]; load_q<64>(qf, PJ + row * PJW + C_NQ + head * 64, h);
                const unsigned mask = SEL[row * 2 + g];
                f32x16 o[2], os[2];
#pragma unroll
                for (int i = 0; i < 16; ++i) { o[0][i] = 0.f; o[1][i] = 0.f; }
                float mx = -INFINITY, l = 0.f;
                attn_block<AM_SEL>(PJ + (size_t)b * SEQ * PJW + C_KSLC + g * 64, VT + (size_t)(R_VSLC + g * 64) * MTOK + (size_t)b * SEQ, (bf16_t*)lds_raw, qf, qb, t0, t, mask, o, mx, l, wave, r, h, tid);
                const float g1 = sigmoidf_(bf2f(PJ[row * PJW + C_GATE + head * 3 + 1])), g2 = sigmoidf_(bf2f(PJ[row * PJW + C_GATE + head * 3 + 2]));
                { const float lt = l + xorl(l, r | (h << 5), 32); const float inv = lt > 0.f ? g1 / lt : 0.f;
#pragma unroll
                  for (int i = 0; i < 16; ++i) { os[0][i] = o[0][i] * inv; os[1][i] = o[1][i] * inv; o[0][i] = 0.f; o[1][i] = 0.f; } }
                mx = -INFINITY; l = 0.f;
                attn_block<AM_WIN>(PJ + (size_t)b * SEQ * PJW + C_KWIN + g * 64, VT + (size_t)(R_VWIN + g * 64) * MTOK + (size_t)b * SEQ, (bf16_t*)lds_raw, qf, qb, t0, t, 0u, o, mx, l, wave, r, h, tid);
                { const float lt = l + xorl(l, r | (h << 5), 32); const float inv = lt > 0.f ? g2 / lt : 0.f;
                  const bf16_t* ocr = OCB + row * 512 + head * 64;
#pragma unroll
                  for (int db = 0; db < 2; ++db)
#pragma unroll
                      for (int jj = 0; jj < 4; ++jj) { const s16x4 cv = *(const s16x4*)(ocr + 32 * db + 8 * jj + 4 * h);
#pragma unroll
                          for (int e = 0; e < 4; ++e) o[db][4 * jj + e] = o[db][4 * jj + e] * inv + os[db][4 * jj + e] + bf2f((bf16_t)cv[e]); } }
                store_o<64>(YS + row * DM + 512 + head * 64, o, h);
            }
        } else if (k == 7) {
            for (int m = gw; m < MTOK / 2; m += NGW) {
                bf16x8 v[2][4]; float ss[2][4];
#pragma unroll
                for (int q = 0; q < 2; ++q)
#pragma unroll
                    for (int gq = 0; gq < 4; ++gq) v[q][gq] = *(const bf16x8*)(YS + ((size_t)m + (size_t)q * (MTOK / 2)) * DM + gq * 512 + 8 * lane);
#pragma unroll
                for (int q = 0; q < 2; ++q)
#pragma unroll
                    for (int gq = 0; gq < 4; ++gq) { float a = 0.f;
#pragma unroll
                        for (int e = 0; e < 8; ++e) { const float f = bf2f((bf16_t)v[q][gq][e]); a += f * f; } ss[q][gq] = a; }
#pragma unroll
                for (int o = 1; o < 64; o <<= 1)
#pragma unroll
                    for (int q = 0; q < 2; ++q)
#pragma unroll
                        for (int gq = 0; gq < 4; ++gq) ss[q][gq] += xorl(ss[q][gq], lane, o);
#pragma unroll
                for (int gq = 0; gq < 4; ++gq) { const float* ng = p.in[I_NG] + ((size_t)L * 4 + gq) * 512 + 8 * lane; const f32x4 n0 = *(const f32x4*)ng, n1 = *(const f32x4*)(ng + 4);
#pragma unroll
                    for (int q = 0; q < 2; ++q) { const float rs = 1.f / sqrtf(ss[q][gq] * (1.f / 512.f) + RMS_EPS); float f[8];
#pragma unroll
                        for (int e = 0; e < 8; ++e) f[e] = bf2f((bf16_t)v[q][gq][e]) * rs;
                        u32x4 w; w.x = pk2(f[0] * n0[0], f[1] * n0[1]); w.y = pk2(f[2] * n0[2], f[3] * n0[3]); w.z = pk2(f[4] * n1[0], f[5] * n1[1]); w.w = pk2(f[6] * n1[2], f[7] * n1[3]);
                        *(u32x4*)(YS + ((size_t)m + (size_t)q * (MTOK / 2)) * DM + gq * 512 + 8 * lane) = w; } } }
        } else if (k == 9 || k == 13 || k == 16) {
            const int gi = k == 9 ? I_L1G : k == 13 ? I_L2G : I_L3G; const bool fin = (k == 16 && L == DEPTH - 1);
            for (int m = gw; m < MTOK / 4; m += NGW) ln_rows_b<4>((const bf16_t*)HF + (size_t)m * DM, (size_t)(MTOK / 4) * DM, p.in[gi] + (size_t)L * DM, p.in[gi + 1] + (size_t)L * DM, fin ? nullptr : HB + (size_t)m * DM, fin ? p.out + (size_t)m * DM : nullptr, lane);
            if (k == 13) { wconv_phase(p, ws, L, scr + wave * (64 * 65), lane, 1, gw, NGW, gridDim.x == 256 ? GU_EARLY : 0, 1 << 30); if (gridDim.x != 256) wconv_phase(p, ws, L, scr + wave * (64 * 65), lane, 2, gw, NGW, 0, 1 << 30); }
        } else if (k == 3) {
            if (gridDim.x == 256 && blockIdx.x >= 16) { wconv_phase(p, ws, L, scr + wave * (64 * 65), lane, 2, ((int)blockIdx.x - 16) * 8 + wave, 240 * 8, 0, 1 << 30);
                wconv_phase(p, ws, L, scr + wave * (64 * 65), lane, 1, ((int)blockIdx.x - 16) * 8 + wave, 240 * 8, 0, GU_EARLY); }
        } else if (k == 11) {
            for (int u = blockIdx.x; u < 256; u += gridDim.x) { const int bh = u & 31, qb = u >> 5; xatt_block(QX, KX, KXT, OX, (bf16_t*)lds_raw, bh >> 2, bh & 3, qb, wave, r, h, tid); }
        }
        if (ph2 + 1 < 2 * ph_hi) { if (sync_after) { if (ph_lo < 0) grid.sync(); else xcd_barrier(xbar); } else __syncthreads(); }
    }
}

__global__ void diag_k(float* out, float code) { if (threadIdx.x == 0) out[0] = code; }
extern "C" void kernel_launch(void* const* d_in, const int* in_sizes, int n_in, void* d_out, int out_size, void* d_ws, size_t ws_size, hipStream_t stream) {
    static int grid = 0;
    if (grid == 0) {
        if (n_in != 32 || ws_size < WS_END) { fprintf(stderr, "kernel_launch: bad inputs n_in %d ws %zu need %zu\n", n_in, ws_size, (size_t)WS_END); grid = -1; }
        if (grid == 0) {
        int dev = 0, cus = 0, per_cu = 0;
        hipGetDevice(&dev); hipDeviceGetAttribute(&cus, hipDeviceAttributeMultiprocessorCount, dev);
        hipFuncSetAttribute((const void*)mk_fwd, hipFuncAttributeMaxDynamicSharedMemorySize, LDS_BYTES);
        hipOccupancyMaxActiveBlocksPerMultiprocessor(&per_cu, (const void*)mk_fwd, 512, LDS_BYTES);
        if (per_cu < 1) per_cu = 1;
        (void)hipGetLastError();
        grid = cus * 1;
        fprintf(stderr, "kernel_launch: grid %d (occupancy %d/CU)\n", grid, per_cu);
        }
    }
    if (grid < 0) { diag_k<<<1, 64, 0, stream>>>((float*)d_out, (n_in == 32 ? (float)(ws_size >> 20) : 1e6f)); return; }
    (void)hipMemsetAsync((char*)d_ws + WS_BAR, 0, WS_BAR_BYTES, stream);
    Params p{};
    for (int i = 0; i < 32; ++i) p.in[i] = (const float*)d_in[i];
    p.out = (float*)d_out; p.ws = (unsigned char*)d_ws;
#ifndef MK_HI
#define MK_HI N_PHASES
#endif
    int lo = 0, hi = MK_HI;
    void* args[] = {&p, &lo, &hi};
    hipError_t e = hipLaunchCooperativeKernel((const void*)mk_fwd, dim3(grid), dim3(512), args, LDS_BYTES, stream);
    if (e != hipSuccess) { fprintf(stderr, "cooperative launch failed: %s (grid %d)\n", hipGetErrorString(e), grid); (void)hipGetLastError(); diag_k<<<1, 64, 0, stream>>>((float*)d_out, 200000.f + (float)(int)e); }
}
```

```cpp
#include <hip/hip_runtime.h>
#include <hip/hip_cooperative_groups.h>
#include <cstdio>
#include <cstdint>
namespace cg = cooperative_groups;

#define DI __device__ __forceinline__
#define LAS __attribute__((address_space(3)))
typedef unsigned short bf16_t;
typedef short bf16x8 __attribute__((ext_vector_type(8)));
typedef short s16x4 __attribute__((ext_vector_type(4)));
typedef float f32x2 __attribute__((ext_vector_type(2)));
typedef float f32x4 __attribute__((ext_vector_type(4)));
typedef float f32x16 __attribute__((ext_vector_type(16)));
typedef unsigned u32x2 __attribute__((ext_vector_type(2)));
typedef unsigned u32x4 __attribute__((ext_vector_type(4)));
typedef __bf16 bf16x2_t __attribute__((ext_vector_type(2)));

constexpr int DM = 2048, BATCH = 8, SEQ = 2048, MTOK = BATCH * SEQ, DEPTH = 2;
constexpr int MEMLEN = 256, FFH = 5632, INW = 4888;
constexpr int PJW = 3840;
constexpr int VTR = 1280;
constexpr int NCMP = 127;
constexpr float ALPHA = 1.4142135623730951f;
constexpr float LN_EPS = 1e-5f, RMS_EPS = 1e-6f;
constexpr int C_U = 0, C_NQ = 512, C_KCMP = 1024, C_VCMP = 1152, C_KSLC = 1280, C_KWIN = 1408, C_SBQ = 1536, C_SBK = 2048, C_DQ = 2560, C_DK = 3072, C_GATE = 3584;
constexpr int R_VSLC = 0, R_VWIN = 128, R_SBV = 256, R_DV = 768;

constexpr size_t al256(size_t x) { return (x + 255) & ~(size_t)255; }
constexpr size_t WS_ROPE = 0;
constexpr size_t WS_WIN = al256(WS_ROPE + 2048 * 32 * 2 * 4);
constexpr size_t WS_WINV = WS_WIN + (size_t)PJW * DM * 2;
constexpr size_t WS_WOUT = WS_WINV + (size_t)VTR * DM * 2;
constexpr size_t WS_WQ = WS_WOUT + (size_t)DM * DM * 2;
constexpr size_t WS_WKV = WS_WQ + (size_t)512 * DM * 2;
constexpr size_t WS_WO = WS_WKV + (size_t)1024 * DM * 2;
constexpr size_t WS_WGLU = WS_WO + (size_t)DM * 512 * 2;
constexpr size_t WS_WC1 = WS_WGLU + (size_t)512 * 512 * 2;

constexpr size_t WS_OCB = WS_WIN;
static_assert((size_t)MTOK * 512 * 2 <= WS_WOUT - WS_WIN, "aliases over weights");
constexpr size_t WS_HF = WS_WC1 + (size_t)256 * DM * 2;
constexpr size_t WS_HB = WS_HF + (size_t)MTOK * DM * 4;
constexpr size_t WS_BIG = WS_HB + (size_t)MTOK * DM * 2;
constexpr size_t WS_PJ = WS_BIG;
constexpr size_t WS_VT = WS_PJ + (size_t)MTOK * PJW * 2;
constexpr size_t WS_CMPA = WS_VT + (size_t)VTR * MTOK * 2;
constexpr size_t WS_GA = WS_WIN;
constexpr size_t WS_ACT = WS_BIG;
constexpr size_t BIG_BYTES = (size_t)MTOK * FFH * 2;
static_assert(WS_CMPA + (size_t)4096 * DM * 2 <= WS_BIG + BIG_BYTES, "big union");
constexpr size_t WS_YS = WS_BIG + BIG_BYTES;
constexpr size_t WS_QX = WS_YS;
constexpr size_t WS_OX = WS_YS + (size_t)MTOK * 512 * 2;
constexpr size_t WS_WGU = WS_HF + (size_t)MTOK * DM * 2;
static_assert((size_t)2 * FFH * DM * 2 <= (size_t)MTOK * DM * 2, "WGU fits in the upper half of HF");
constexpr size_t WS_MEMB = WS_YS + (size_t)MTOK * DM * 2;
constexpr size_t WS_KX = WS_MEMB + (size_t)2048 * DM * 2;
constexpr size_t WS_KXT = WS_KX + (size_t)2048 * 1024 * 2;
constexpr size_t WS_HC = WS_KXT + (size_t)1024 * 2048 * 2;
constexpr size_t WS_KC = WS_HC + (size_t)4096 * 256 * 2;
constexpr size_t WS_VCT = WS_KC + (size_t)8 * 2 * 128 * 64 * 2;
constexpr size_t WS_SEL = WS_VCT + (size_t)8 * 2 * 64 * 128 * 2;
constexpr size_t WS_S5E = WS_SEL + (size_t)MTOK * 2 * 4;
constexpr size_t WS_BAR = WS_S5E + (size_t)8 * 32 * 32 * 64 * 8;
constexpr size_t WS_BAR_BYTES = 16384;
constexpr size_t WS_WD = WS_BAR + WS_BAR_BYTES;
constexpr size_t WS_END = WS_WD + (size_t)DM * FFH * 2;

constexpr int LDS_BYTES = 131072 + 8192;

DI float bf2f(bf16_t v) { return __builtin_bit_cast(float, (unsigned)v << 16); }
DI unsigned pk2(float lo, float hi) { f32x2 v = {lo, hi}; bf16x2_t b = __builtin_convertvector(v, bf16x2_t); return __builtin_bit_cast(unsigned, b); }
DI bf16_t f2bf(float f) { return (bf16_t)(pk2(f, 0.f) & 0xffffu); }
DI float xorl(float v, int lane, int m) { return __builtin_bit_cast(float, __builtin_amdgcn_ds_bpermute((lane ^ m) << 2, __builtin_bit_cast(int, v))); }
DI float wave_sum(float v, int lane) {
#pragma unroll
    for (int o = 1; o < 64; o <<= 1) v += xorl(v, lane, o);
    return v;
}
DI float sigmoidf_(float x) { return __builtin_amdgcn_rcpf(1.f + __expf(-x)); }
DI float gelu_tanh(float x) { const float u = 0.7978845608028654f * (x + 0.044715f * x * x * x); return x * __builtin_amdgcn_rcpf(1.f + __expf(-2.f * u)); }
DI float opq(float x) { asm volatile("" : "+s"(x)); return x; }
DI void sincos_acc(float x, float& s, float& c) {
    const float k = rintf(x * 0.63661977236758134308f);
    float r = fmaf(-k, 1.5707963705062866f, x); r = fmaf(-k, -4.371138828673793e-08f, r); r = fmaf(-k, -1.7763568394002505e-15f, r);
    const int q = (int)k & 3; const float r2 = r * r;
    const float sp = fmaf(r * r2, fmaf(r2, fmaf(r2, opq(-1.9515295891e-4f), opq(8.3321608736e-3f)), opq(-1.6666654611e-1f)), r);
    const float cp = fmaf(r2 * r2, fmaf(r2, fmaf(r2, opq(2.443315711809948e-5f), opq(-1.388731625493765e-3f)), opq(4.166664568298827e-2f)), fmaf(r2, -0.5f, 1.0f));
    float sv, cv;
    if (q == 0) { sv = sp; cv = cp; } else if (q == 1) { sv = cp; cv = -sp; } else if (q == 2) { sv = -sp; cv = -cp; } else { sv = -cp; cv = sp; }
    s = sv; c = cv;
}

namespace pg8 {
constexpr int BM = 256, BK = 64, HALF = 128, HTB = HALF * BK * 2, NXCD = 8, WGM = 8;
__host__ __device__ __forceinline__ int lds_byte(int r, int c) { const int st = (r >> 4) * 2 + (c >> 5), rr = r & 15, cc = c & 31, ob = rr * 64 + cc * 2; return st * 1024 + (ob ^ (((ob >> 9) & 1) << 5)); }
__host__ __device__ __forceinline__ void stage_rc(int b, int& R, int& C) { const int st = b / 1024, sb = b % 1024, swz = sb ^ (((sb >> 9) & 1) << 5); R = (st >> 1) * 16 + swz / 64; C = (st & 1) * 32 + (swz % 64) / 2; }
__host__ __device__ __forceinline__ int perm32(int rho) { const int n = rho >> 4, i = rho & 15; return 8 * (i >> 2) + 4 * n + (i & 3); }
struct Unit { int pm, pn; };
struct Gemm { const bf16_t* A; const bf16_t* Bt; int M, N, K; };
struct StaticOrder {
    int nM, nN, nwg, G, c;
    __device__ void init(int M, int N, int G_, int c_) { nM = M / BM; nN = N / BM; nwg = nM * nN; G = G_; c = c_; }
    __device__ bool next(int i, Unit& u) const {
        const long L = (long)i * G + c; if (L >= nwg) return false;
        int wgid = (int)L; { const int q = nwg / NXCD, r = nwg % NXCD, xcd = wgid % NXCD, off = wgid / NXCD; wgid = (xcd < r ? xcd * (q + 1) : r * (q + 1) + (xcd - r) * q) + off; }
        const int nig = WGM * nN, gid = wgid / nig, fm = gid * WGM, gsz = (nM - fm) < WGM ? (nM - fm) : WGM;
        u.pm = fm + ((wgid % nig) % gsz); u.pn = (wgid % nig) / gsz; return true;
    }
    DI void a_ready(const Unit&) const {}
    DI void done(const Unit&) const {}
};

struct EpiAny {
    static constexpr bool PERM = true, AFTER_DRAIN = false;
    int mode; void* out; int ldc; const void* aux1; const void* aux2;
    DI void operator()(const f32x4 (&acc)[2][2][4][2], const Unit& u, int wr, int wc, int fr, int fq) const {
        const int row0 = u.pm * BM + wr * 64 + fr;
        if (mode <= 1) {
            bf16_t* O = (bf16_t*)out; const int col0 = u.pn * BM + wc * 32 + 8 * fq;
#pragma unroll
            for (int ai = 0; ai < 2; ++ai)
#pragma unroll
                for (int m = 0; m < 4; ++m) { bf16_t* rowp = O + (size_t)(row0 + ai * HALF + m * 16) * ldc + col0;
#pragma unroll
                    for (int bj = 0; bj < 2; ++bj) { f32x4 v0 = acc[ai][bj][m][0], v1 = acc[ai][bj][m][1];
                        if (mode == 1) {
#pragma unroll
                            for (int j = 0; j < 4; ++j) { v0[j] = gelu_tanh(v0[j]); v1[j] = gelu_tanh(v1[j]); } }
                        u32x4 w; w.x = pk2(v0[0], v0[1]); w.y = pk2(v0[2], v0[3]); w.z = pk2(v1[0], v1[1]); w.w = pk2(v1[2], v1[3]);
                        *(u32x4*)(rowp + bj * HALF) = w; } }
        } else if (mode == 2) {
            bf16_t* H = (bf16_t*)out; const bf16_t* HBp = (const bf16_t*)aux1; const int col0 = u.pn * BM + wc * 32 + 8 * fq;
#pragma unroll
            for (int ai = 0; ai < 2; ++ai)
#pragma unroll
                for (int m = 0; m < 4; ++m) { const size_t ro = (size_t)(row0 + ai * HALF + m * 16) * ldc + col0;
#pragma unroll
                    for (int bj = 0; bj < 2; ++bj) { const bf16x8 hv = *(const bf16x8*)(HBp + ro + bj * HALF); f32x4 a, b;
#pragma unroll
                        for (int j = 0; j < 4; ++j) { a[j] = bf2f((bf16_t)hv[j]) * ALPHA + acc[ai][bj][m][0][j]; b[j] = bf2f((bf16_t)hv[4 + j]) * ALPHA + acc[ai][bj][m][1][j]; }
                        u32x4 w; w.x = pk2(a[0], a[1]); w.y = pk2(a[2], a[3]); w.z = pk2(b[0], b[1]); w.w = pk2(b[2], b[3]);
                        *(u32x4*)(H + ro + bj * HALF) = w; } }
        } else if (mode == 3) {
            bf16_t* O = (bf16_t*)out; const int col0 = u.pn * HALF + wc * 32 + 8 * fq;
#pragma unroll
            for (int ai = 0; ai < 2; ++ai)
#pragma unroll
                for (int m = 0; m < 4; ++m) { bf16_t* rowp = O + (size_t)(row0 + ai * HALF + m * 16) * ldc + col0;
                    f32x4 g0 = acc[ai][0][m][0], g1 = acc[ai][0][m][1], u0 = acc[ai][1][m][0], u1 = acc[ai][1][m][1];
#pragma unroll
                    for (int j = 0; j < 4; ++j) { g0[j] = g0[j] * sigmoidf_(g0[j]) * u0[j]; g1[j] = g1[j] * sigmoidf_(g1[j]) * u1[j]; }
                    u32x4 w; w.x = pk2(g0[0], g0[1]); w.y = pk2(g0[2], g0[3]); w.z = pk2(g1[0], g1[1]); w.w = pk2(g1[2], g1[3]);
                    *(u32x4*)rowp = w; }
        } else {
            bf16_t* O = (bf16_t*)out; const bf16_t* G = (const bf16_t*)aux1; const float* bia = (const float*)aux2; const int col0 = u.pn * BM + wc * 32 + 8 * fq;
#pragma unroll
            for (int ai = 0; ai < 2; ++ai)
#pragma unroll
                for (int m = 0; m < 4; ++m) { const int row = row0 + ai * HALF + m * 16;
#pragma unroll
                    for (int bj = 0; bj < 2; ++bj) { const int col = col0 + bj * HALF; f32x4 v0 = acc[ai][bj][m][0], v1 = acc[ai][bj][m][1];
                        const bf16x8 gv = *(const bf16x8*)(G + (size_t)row * 512 + col); const f32x4 b0 = *(const f32x4*)(bia + col), b1 = *(const f32x4*)(bia + col + 4);
#pragma unroll
                        for (int j = 0; j < 4; ++j) { v0[j] = bf2f((bf16_t)gv[j]) * sigmoidf_(v0[j] + b0[j]); v1[j] = bf2f((bf16_t)gv[4 + j]) * sigmoidf_(v1[j] + b1[j]); }
                        u32x4 w; w.x = pk2(v0[0], v0[1]); w.y = pk2(v0[2], v0[3]); w.z = pk2(v1[0], v1[1]); w.w = pk2(v1[2], v1[3]);
                        *(u32x4*)(O + (size_t)row * ldc + col) = w; } }
        }
    }
};

template <class Epi, class Sched, bool ALIGN_EPI = false, bool SP2 = false>
__device__ __forceinline__ void gemm_phase(LAS unsigned char* lds, const Gemm g, const Sched& S, const Epi& E, const int tid) {
    const int wid = __builtin_amdgcn_readfirstlane(tid >> 6), lane = tid & 63, wr = wid >> 2, wc = wid & 3, fr = lane & 15, fq = lane >> 4;
    const int K = g.K, nt = K / BK;
    unsigned voffA[2], voffB[2];
#pragma unroll
    for (int i = 0; i < 2; ++i) { int R, C; stage_rc(tid * 16 + i * 8192, R, C); const int Rb = Epi::PERM ? ((R & ~31) + perm32(R & 31)) : R;
        voffA[i] = (unsigned)(R * K + C) * 2u; voffB[i] = (unsigned)(Rb * K + C) * 2u; }
    const size_t kstep = (size_t)(BK * 2);
    const size_t hstep = (size_t)HALF * K * 2;
    const size_t tstep = 2 * hstep;
    const unsigned ldsw = (unsigned)wid * 1024u;
    const int aoff = lds_byte(wr * 64 + fr, fq * 8), boff = lds_byte(wc * 32 + fr, fq * 8);
#define PG8_SA(b, h) (((b) * 2 + (h)) * HTB)
#define PG8_SB(b, h) ((4 + (b) * 2 + (h)) * HTB)
#define PG8_STAGE(bufoff, gbase, voff) do { _Pragma("unroll") for (int _i = 0; _i < 2; ++_i) \
        __builtin_amdgcn_global_load_lds((const unsigned*)((const char*)(gbase) + (voff)[_i]), (LAS unsigned*)(lds + (bufoff) + ldsw + _i * 8192), 16, 0, 0); } while (0)
#define PG8_LDA(dst, b, h) do { _Pragma("unroll") for (int m = 0; m < 4; ++m) _Pragma("unroll") for (int k = 0; k < 2; ++k) dst[m][k] = *(const LAS bf16x8*)(lds + PG8_SA(b, h) + aoff + m * 2048 + k * 1024); } while (0)
#define PG8_LDB(dst, b, h) do { _Pragma("unroll") for (int n = 0; n < 2; ++n) _Pragma("unroll") for (int k = 0; k < 2; ++k) dst[n][k] = *(const LAS bf16x8*)(lds + PG8_SB(b, h) + boff + n * 2048 + k * 1024); } while (0)
#define PG8_MMA(ai, bj, At, Bt) do { __builtin_amdgcn_s_setprio(1); _Pragma("unroll") for (int m = 0; m < 4; ++m) _Pragma("unroll") for (int n = 0; n < 2; ++n) _Pragma("unroll") for (int k = 0; k < 2; ++k) \
        acc[ai][bj][m][n] = __builtin_amdgcn_mfma_f32_16x16x32_bf16(Bt[n][k], At[m][k], acc[ai][bj][m][n], 0, 0, 0); __builtin_amdgcn_s_setprio(0); } while (0)
#define PG8_WAIT_V(n) asm volatile("s_waitcnt vmcnt(" #n ")" ::: "memory")
#define PG8_WAIT_L(n) asm volatile("s_waitcnt lgkmcnt(" #n ")" ::: "memory")
#define PG8_BAR __builtin_amdgcn_s_barrier()
#define PG8_SCHED __builtin_amdgcn_sched_barrier(0)
    Unit cur, nxt; int ui = 0;
    if (!S.next(0, cur)) return;
    f32x4 acc[2][2][4][2];
#pragma unroll
    for (int a = 0; a < 2; ++a)
#pragma unroll
        for (int b = 0; b < 2; ++b)
#pragma unroll
            for (int m = 0; m < 4; ++m)
#pragma unroll
                for (int n = 0; n < 2; ++n) acc[a][b][m][n] = (f32x4){0.f, 0.f, 0.f, 0.f};
    bf16x8 At[4][2], B0[2][2], B1[2][2];
    const char* cA = (const char*)g.A + (size_t)cur.pm * tstep; const char* cB = (const char*)g.Bt + (size_t)cur.pn * tstep;
    S.a_ready(cur);
    if constexpr (SP2) {
        PG8_STAGE(PG8_SB(0, 0), cB, voffB); PG8_STAGE(PG8_SB(0, 1), cB + hstep, voffB); PG8_STAGE(PG8_SA(0, 0), cA, voffA); PG8_STAGE(PG8_SA(0, 1), cA + hstep, voffA);
        if (wr == 1) PG8_BAR;
        PG8_WAIT_V(2); PG8_BAR;
        PG8_STAGE(PG8_SB(1, 0), cB + kstep, voffB); PG8_STAGE(PG8_SA(1, 0), cA + kstep, voffA); PG8_STAGE(PG8_SB(1, 1), cB + hstep + kstep, voffB);
        PG8_WAIT_V(6); PG8_BAR;
    } else {
        PG8_STAGE(PG8_SB(0, 0), cB, voffB); PG8_STAGE(PG8_SA(0, 0), cA, voffA); PG8_STAGE(PG8_SB(0, 1), cB + hstep, voffB); PG8_STAGE(PG8_SA(0, 1), cA + hstep, voffA);
        if (wr == 1) PG8_BAR;
        PG8_WAIT_V(4); PG8_BAR;
        PG8_STAGE(PG8_SB(1, 0), cB + kstep, voffB); PG8_STAGE(PG8_SA(1, 0), cA + kstep, voffA); PG8_STAGE(PG8_SB(1, 1), cB + hstep + kstep, voffB);
        PG8_WAIT_V(6); PG8_BAR;
    }
    for (;;) {
        const bool has_next = S.next(ui + 1, nxt);
        const char* nA = has_next ? (const char*)g.A + (size_t)nxt.pm * tstep : cA; const char* nB = has_next ? (const char*)g.Bt + (size_t)nxt.pn * tstep : cB;
        for (int t = 0; t < nt; t += 2) {
            const bool last = (t == nt - 2);
            const char* a1 = cA + (size_t)(t + 1) * kstep;
            const char* a2 = last ? nA : cA + (size_t)(t + 2) * kstep; const char* b2 = last ? nB : cB + (size_t)(t + 2) * kstep;
            const char* a3 = a2 + kstep; const char* b3 = b2 + kstep;
            if (last && has_next) S.a_ready(nxt);
            if constexpr (SP2) {
            PG8_LDB(B0, 0, 0); PG8_LDB(B1, 0, 1); PG8_SCHED; PG8_LDA(At, 0, 0); PG8_STAGE(PG8_SA(1, 1), a1 + hstep, voffA);
            PG8_WAIT_V(8); PG8_WAIT_L(0); PG8_BAR; PG8_MMA(0, 0, At, B0); PG8_MMA(0, 1, At, B1); PG8_BAR; PG8_SCHED;
            PG8_LDA(At, 0, 1); PG8_STAGE(PG8_SB(0, 0), b2, voffB); PG8_STAGE(PG8_SB(0, 1), b2 + hstep, voffB); PG8_STAGE(PG8_SA(0, 0), a2, voffA);
            PG8_WAIT_V(8); PG8_WAIT_L(0); PG8_BAR; PG8_MMA(1, 0, At, B0); PG8_MMA(1, 1, At, B1); PG8_BAR; PG8_SCHED;
            PG8_LDB(B0, 1, 0); PG8_LDB(B1, 1, 1); PG8_SCHED; PG8_LDA(At, 1, 0); PG8_STAGE(PG8_SA(0, 1), a2 + hstep, voffA);
            PG8_WAIT_V(8); PG8_WAIT_L(0); PG8_BAR; PG8_MMA(0, 0, At, B0); PG8_MMA(0, 1, At, B1); PG8_BAR; PG8_SCHED;
            PG8_LDA(At, 1, 1); PG8_STAGE(PG8_SB(1, 0), b3, voffB); PG8_STAGE(PG8_SB(1, 1), b3 + hstep, voffB); PG8_STAGE(PG8_SA(1, 0), a3, voffA);
            PG8_WAIT_V(8); PG8_WAIT_L(0); PG8_BAR; PG8_MMA(1, 0, At, B0); PG8_MMA(1, 1, At, B1); PG8_BAR; PG8_SCHED;
            } else {
            PG8_LDB(B0, 0, 0); PG8_SCHED; PG8_LDA(At, 0, 0); PG8_STAGE(PG8_SA(1, 1), a1 + hstep, voffA);
            PG8_WAIT_L(8); PG8_BAR; PG8_WAIT_L(0); PG8_MMA(0, 0, At, B0); PG8_BAR; PG8_SCHED;
            PG8_LDB(B1, 0, 1); PG8_STAGE(PG8_SB(0, 0), b2, voffB);
            PG8_BAR; PG8_WAIT_L(0); PG8_MMA(0, 1, At, B1); PG8_BAR;
            PG8_LDA(At, 0, 1); PG8_STAGE(PG8_SA(0, 0), a2, voffA);
            PG8_BAR; PG8_WAIT_L(0); PG8_MMA(1, 0, At, B0); PG8_BAR; PG8_SCHED;
            PG8_STAGE(PG8_SB(0, 1), b2 + hstep, voffB);
            PG8_WAIT_V(6); PG8_BAR; PG8_MMA(1, 1, At, B1); PG8_BAR;
            PG8_LDB(B0, 1, 0); PG8_SCHED; PG8_LDA(At, 1, 0); PG8_STAGE(PG8_SA(0, 1), a2 + hstep, voffA);
            PG8_WAIT_L(8); PG8_BAR; PG8_WAIT_L(0); PG8_MMA(0, 0, At, B0); PG8_BAR; PG8_SCHED;
            PG8_LDB(B1, 1, 1); PG8_STAGE(PG8_SB(1, 0), b3, voffB);
            PG8_BAR; PG8_WAIT_L(0); PG8_MMA(0, 1, At, B1); PG8_BAR;
            PG8_LDA(At, 1, 1); PG8_STAGE(PG8_SA(1, 0), a3, voffA);
            PG8_BAR; PG8_WAIT_L(0); PG8_MMA(1, 0, At, B0); PG8_BAR; PG8_SCHED;
            PG8_STAGE(PG8_SB(1, 1), b3 + hstep, voffB);
            PG8_WAIT_V(6); PG8_BAR; PG8_MMA(1, 1, At, B1); PG8_BAR;
            }
        }
        if constexpr (ALIGN_EPI) { if (wr == 0) PG8_BAR; }
        if constexpr (!Epi::AFTER_DRAIN) { E(acc, cur, wr, wc, fr, fq); S.done(cur); }
        if (!has_next) break;
#pragma unroll
        for (int a = 0; a < 2; ++a)
#pragma unroll
            for (int b = 0; b < 2; ++b)
#pragma unroll
                for (int m = 0; m < 4; ++m)
#pragma unroll
                    for (int n = 0; n < 2; ++n) acc[a][b][m][n] = (f32x4){0.f, 0.f, 0.f, 0.f};
        cur = nxt; cA = nA; cB = nB; ++ui;
        if constexpr (ALIGN_EPI) { if (wr == 1) PG8_BAR; }
    }
    PG8_WAIT_V(0);
    if constexpr (!ALIGN_EPI) { if (wr == 0) PG8_BAR; }
    PG8_BAR;
#undef PG8_SA
#undef PG8_SB
#undef PG8_STAGE
#undef PG8_LDA
#undef PG8_LDB
#undef PG8_MMA
#undef PG8_WAIT_V
#undef PG8_WAIT_L
#undef PG8_BAR
#undef PG8_SCHED
}
}

struct Params { const float* in[32]; float* out; unsigned char* ws; };
enum { I_X = 0, I_MEM, I_LNG, I_LNB, I_WIN, I_LRE, I_LIM, I_LDT, I_BRE, I_BIM, I_CRE, I_CIM, I_SD, I_WGLU, I_BGLU, I_PE, I_CW1, I_CW2, I_NG, I_WOUT, I_L1G, I_L1B, I_WQ, I_WKV, I_WO, I_L2G, I_L2B, I_FG, I_FU, I_FD, I_L3G, I_L3B };

#define MFMA32(a, b, c) __builtin_amdgcn_mfma_f32_32x32x16_bf16((a), (b), (c), 0, 0, 0)
DI int crow(int i, int h) { return (i & 3) + 8 * (i >> 2) + 4 * h; }
template <int D> DI f32x16 qk_tile(const bf16_t* Kb, int ldk, const bf16x8 (&qf)[D / 16], int r, int h) {
    f32x16 s;
#pragma unroll
    for (int i = 0; i < 16; ++i) s[i] = 0.f;
    const bf16_t* kp = Kb + (size_t)r * ldk + 8 * h;
#pragma unroll
    for (int kk = 0; kk < D / 16; ++kk) { const bf16x8 kf = *(const bf16x8*)(kp + 16 * kk); s = MFMA32(kf, qf[kk], s); }
    return s;
}
template <int S_> DI bf16x8 pack8(const f32x16& p) {
    u32x4 w; w.x = pk2(p[8 * S_ + 0], p[8 * S_ + 1]); w.y = pk2(p[8 * S_ + 2], p[8 * S_ + 3]); w.z = pk2(p[8 * S_ + 4], p[8 * S_ + 5]); w.w = pk2(p[8 * S_ + 6], p[8 * S_ + 7]);
    return __builtin_bit_cast(bf16x8, w);
}
template <int D> DI void pv_tile(f32x16 (&o)[D / 32], const bf16_t* Vb, size_t ldv, const f32x16& p, int r, int h) {
    const bf16x8 p0 = pack8<0>(p), p1 = pack8<1>(p);
#pragma unroll
    for (int db = 0; db < D / 32; ++db) {
        const bf16_t* vp = Vb + (size_t)(32 * db + r) * ldv + 4 * h;
        const s16x4 a0 = *(const s16x4*)(vp), a1 = *(const s16x4*)(vp + 8), b0 = *(const s16x4*)(vp + 16), b1 = *(const s16x4*)(vp + 24);
        const bf16x8 va0 = __builtin_shufflevector(a0, a1, 0, 1, 2, 3, 4, 5, 6, 7), va1 = __builtin_shufflevector(b0, b1, 0, 1, 2, 3, 4, 5, 6, 7);
        o[db] = MFMA32(va0, p0, o[db]); o[db] = MFMA32(va1, p1, o[db]);
    }
}
DI void osm(const f32x16& s2, const f32x16& wgt, float& mx, float& l, f32x16& p, float& corr, const int r, const int h) {
    float tm = -INFINITY;
#pragma unroll
    for (int i = 0; i < 16; ++i) tm = wgt[i] > 0.f ? fmaxf(tm, s2[i]) : tm;
    tm = fmaxf(tm, xorl(tm, r | (h << 5), 32));
    const float mn = fmaxf(mx, tm); const float ms = (mn == -INFINITY) ? 0.f : mn;
    corr = __builtin_amdgcn_exp2f(mx - ms);
    float ps = 0.f;
#pragma unroll
    for (int i = 0; i < 16; ++i) { p[i] = wgt[i] > 0.f ? wgt[i] * __builtin_amdgcn_exp2f(s2[i] - ms) : 0.f; ps += p[i]; }
    l = l * corr + ps; mx = mn;
}
DI void osm_b(const f32x16& s2, float& mx, float& l, f32x16& p, float& corr, const int r, const int h) {
    float tm = fmaxf(fmaxf(fmaxf(s2[0], s2[1]), fmaxf(s2[2], s2[3])), fmaxf(fmaxf(s2[4], s2[5]), fmaxf(s2[6], s2[7])));
    tm = fmaxf(tm, fmaxf(fmaxf(fmaxf(s2[8], s2[9]), fmaxf(s2[10], s2[11])), fmaxf(fmaxf(s2[12], s2[13]), fmaxf(s2[14], s2[15]))));
    tm = fmaxf(tm, xorl(tm, r | (h << 5), 32));
    const float mn = fmaxf(mx, tm); const float ms = (mn == -INFINITY) ? 0.f : mn;
    corr = __builtin_amdgcn_exp2f(mx - ms);
    float ps = 0.f;
#pragma unroll
    for (int i = 0; i < 16; ++i) { p[i] = __builtin_amdgcn_exp2f(s2[i] - ms); ps += p[i]; }
    l = l * corr + ps; mx = mn;
}
template <int D> DI void load_q(bf16x8 (&qf)[D / 16], const bf16_t* qrow, int h) {
#pragma unroll
    for (int kk = 0; kk < D / 16; ++kk) qf[kk] = *(const bf16x8*)(qrow + 16 * kk + 8 * h);
}
template <int D> DI void store_o(bf16_t* orow, const f32x16 (&o)[D / 32], int h) {
#pragma unroll
    for (int db = 0; db < D / 32; ++db)
#pragma unroll
        for (int jj = 0; jj < 4; ++jj) { u32x2 w; w.x = pk2(o[db][4 * jj], o[db][4 * jj + 1]); w.y = pk2(o[db][4 * jj + 2], o[db][4 * jj + 3]); *(u32x2*)(orow + 32 * db + 8 * jj + 4 * h) = w; }
}
constexpr float L2E = 1.4426950408889634f;

template <int D> DI void load_k(bf16x8 (&kf)[D / 16], const bf16_t* Kb, int ldk, int r, int h) {
    const bf16_t* kp = Kb + (size_t)r * ldk + 8 * h;
#pragma unroll
    for (int kk = 0; kk < D / 16; ++kk) kf[kk] = *(const bf16x8*)(kp + 16 * kk);
}
template <int D> DI f32x16 qk_mm(const bf16x8 (&kf)[D / 16], const bf16x8 (&qf)[D / 16]) {
    f32x16 s;
#pragma unroll
    for (int i = 0; i < 16; ++i) s[i] = 0.f;
#pragma unroll
    for (int kk = 0; kk < D / 16; ++kk) s = MFMA32(kf[kk], qf[kk], s);
    return s;
}
template <int D> DI void load_v(s16x4 (&vf)[D / 32][4], const bf16_t* Vb, size_t ldv, int r, int h) {
#pragma unroll
    for (int db = 0; db < D / 32; ++db) { const bf16_t* vp = Vb + (size_t)(32 * db + r) * ldv + 4 * h;
        vf[db][0] = *(const s16x4*)(vp); vf[db][1] = *(const s16x4*)(vp + 8); vf[db][2] = *(const s16x4*)(vp + 16); vf[db][3] = *(const s16x4*)(vp + 24); }
}
template <int D> DI void pv_mm(f32x16 (&o)[D / 32], const s16x4 (&vf)[D / 32][4], const f32x16& p) {
    const bf16x8 p0 = pack8<0>(p), p1 = pack8<1>(p);
#pragma unroll
    for (int db = 0; db < D / 32; ++db) {
        const bf16x8 va0 = __builtin_shufflevector(vf[db][0], vf[db][1], 0, 1, 2, 3, 4, 5, 6, 7), va1 = __builtin_shufflevector(vf[db][2], vf[db][3], 0, 1, 2, 3, 4, 5, 6, 7);
        o[db] = MFMA32(va0, p0, o[db]); o[db] = MFMA32(va1, p1, o[db]); }
}
#define CPK4(dst, src) do { dst[0] = src[0]; dst[1] = src[1]; dst[2] = src[2]; dst[3] = src[3]; } while (0)

DI void sb_unit(const bf16_t* PJ, const bf16_t* VT, bf16_t* YS, int b, int head, int qt, int r, int h) {
    const int t0 = qt * 32, t = t0 + r; const size_t row = (size_t)b * SEQ + t;
    bf16x8 qf[4]; load_q<64>(qf, PJ + row * PJW + C_SBQ + head * 64, h);
    const bf16_t* Kb = PJ + (size_t)b * SEQ * PJW + C_SBK + head * 64; const bf16_t* Vb = VT + (size_t)(R_SBV + head * 64) * MTOK + (size_t)b * SEQ;
    f32x16 o[2];
#pragma unroll
    for (int i = 0; i < 16; ++i) { o[0][i] = 0.f; o[1][i] = 0.f; }
    float carry = 0.f;
    bf16x8 kA[4], kN[4]; s16x4 vA[2][4];
    load_k<64>(kA, Kb + (size_t)t0 * PJW, PJW, r, h);
#pragma unroll 1
    for (int kt = qt; kt >= 0; --kt) {
        const int k0 = kt * 32, kn = (kt > 0 ? kt - 1 : 0) * 32;
        load_v<64>(vA, Vb + k0, MTOK, r, h);
        load_k<64>(kN, Kb + (size_t)kn * PJW, PJW, r, h);
        f32x16 s = qk_mm<64>(kA, qf);
        f32x16 lfm, ls;
#pragma unroll
        for (int i = 0; i < 16; ++i) { const float z = s[i] * 0.125f; const float sp = fmaxf(z, 0.f) + __logf(1.f + __expf(-fabsf(z)));
            const bool valid = (k0 + crow(i, h)) < t; lfm[i] = valid ? -sp : 0.f; ls[i] = valid ? (z - sp) : -INFINITY; }
        float G[4], Gp[4];
#pragma unroll
        for (int j = 0; j < 4; ++j) { G[j] = (lfm[4 * j] + lfm[4 * j + 1]) + (lfm[4 * j + 2] + lfm[4 * j + 3]); Gp[j] = xorl(G[j], r | (h << 5), 32); }
        float run = carry; f32x16 w;
#pragma unroll
        for (int j = 3; j >= 0; --j) { const float gh1 = h ? G[j] : Gp[j], gh0 = h ? Gp[j] : G[j]; float a = run + (h ? 0.f : gh1);
            w[4 * j + 3] = __expf(ls[4 * j + 3] + a); a += lfm[4 * j + 3];
            w[4 * j + 2] = __expf(ls[4 * j + 2] + a); a += lfm[4 * j + 2];
            w[4 * j + 1] = __expf(ls[4 * j + 1] + a); a += lfm[4 * j + 1];
            w[4 * j + 0] = __expf(ls[4 * j + 0] + a);
            run += gh1 + gh0; }
        carry = run;
        pv_mm<64>(o, vA, w);
        CPK4(kA, kN);
        if (__all(carry < -110.f)) break;
    }
    store_o<64>(YS + row * DM + 1024 + head * 64, o, h);
}

DI void dil_unit(const bf16_t* PJ, const bf16_t* VT, bf16_t* YS, int b, int head, int qt, int r, int h) {
    const int t0 = qt * 32, t = t0 + r; const size_t row = (size_t)b * SEQ + t;
    bf16x8 qf[4]; load_q<64>(qf, PJ + row * PJW + C_DQ + head * 64, h);
    const bf16_t* Kb = PJ + (size_t)b * SEQ * PJW + C_DK + head * 64; const bf16_t* Vb = VT + (size_t)(R_DV + head * 64) * MTOK + (size_t)b * SEQ;
    f32x16 o[2];
#pragma unroll
    for (int i = 0; i < 16; ++i) { o[0][i] = 0.f; o[1][i] = 0.f; }
    float mx = -INFINITY, l = 0.f;
    bf16x8 kA[4], kN[4]; s16x4 vA[2][4];
    load_k<64>(kA, Kb, PJW, r, h);
#pragma unroll 1
    for (int kt = 0; kt <= qt; ++kt) {
        const int k0 = kt * 32, kn = (kt < qt ? kt + 1 : qt) * 32;
        load_v<64>(vA, Vb + k0, MTOK, r, h);
        load_k<64>(kN, Kb + (size_t)kn * PJW, PJW, r, h);
        f32x16 s = qk_mm<64>(kA, qf);
        f32x16 wgt, p;
#pragma unroll
        for (int i = 0; i < 16; ++i) { const int dl = t - (k0 + crow(i, h)); s[i] *= 0.125f * L2E;
            const int m = (dl <= 128 ? 1 : 0) + (((dl & 3) == 0 && dl <= 512) ? 1 : 0) + (((dl & 15) == 0) ? 1 : 0);
            wgt[i] = dl >= 0 ? (float)m : 0.f; }
        float corr; osm(s, wgt, mx, l, p, corr, r, h);
#pragma unroll
        for (int i = 0; i < 16; ++i) { o[0][i] *= corr; o[1][i] *= corr; }
        pv_mm<64>(o, vA, p);
        CPK4(kA, kN);
    }
    const float lt = l + xorl(l, r | (h << 5), 32); const float inv = lt > 0.f ? 1.f / lt : 0.f;
#pragma unroll
    for (int i = 0; i < 16; ++i) { o[0][i] *= inv; o[1][i] *= inv; }
    store_o<64>(YS + row * DM + 1536 + head * 64, o, h);
}

DI void nsa_a_unit(const bf16_t* PJ, const bf16_t* KC, const bf16_t* VCT, bf16_t* OCB, unsigned* SEL, int b, int g, int qt, int r, int h, float* wl) {
    const int t0 = qt * 32, t = t0 + r; const size_t row = (size_t)b * SEQ + t;
    float* ownl = wl + r * 33; float* spll = wl + 32 * 33 + r * 33;
#pragma unroll
    for (int m = 0; m < 16; ++m) { ownl[2 * m + h] = 0.f; spll[2 * m + h] = 0.f; }
    const bf16_t* kcb = KC + (size_t)(b * 2 + g) * 128 * 64; const bf16_t* vcb = VCT + (size_t)(b * 2 + g) * 64 * 128;
    const int ntile = (t0 + 31 >= 31) ? ((((t0 + 31 - 31) >> 4) >> 5) + 1) : 0;
#pragma unroll 1
    for (int r4 = 0; r4 < 4; ++r4) {
        const int head = g * 4 + r4;
        __builtin_amdgcn_sched_barrier(0);
        bf16x8 qf[4]; load_q<64>(qf, PJ + row * PJW + C_NQ + head * 64, h);
        float tm = -INFINITY, den = 0.f;
        bf16x8 kA[4]; s16x4 vA[2][4];
#pragma unroll 1
        for (int T = 0; T < ntile; ++T) {
            load_k<64>(kA, kcb + (size_t)(32 * T) * 64, 64, r, h);
            f32x16 s = qk_mm<64>(kA, qf); float tl = -INFINITY;
#pragma unroll
            for (int i = 0; i < 16; ++i) { const int c = 32 * T + crow(i, h); const bool valid = (c < NCMP) && (16 * c + 31 <= t); s[i] = valid ? s[i] * (0.125f * L2E) : -INFINITY; tl = fmaxf(tl, s[i]); }
            const float mn = fmaxf(tm, tl), ms = (mn == -INFINITY) ? 0.f : mn; float ps = 0.f;
#pragma unroll
            for (int i = 0; i < 16; ++i) ps += __builtin_amdgcn_exp2f(s[i] - ms);
            den = den * __builtin_amdgcn_exp2f(tm - ms) + ps; tm = mn; }
        { const float to = xorl(tm, r | (h << 5), 32), dn = xorl(den, r | (h << 5), 32); const float mn = fmaxf(tm, to), ms = (mn == -INFINITY) ? 0.f : mn;
          den = den * __builtin_amdgcn_exp2f(tm - ms) + dn * __builtin_amdgcn_exp2f(to - ms); tm = ms; }
        const float inv = 1.f / fmaxf(den, 1e-30f);
        __builtin_amdgcn_sched_barrier(0);
        f32x16 o[2];
#pragma unroll
        for (int i = 0; i < 16; ++i) { o[0][i] = 0.f; o[1][i] = 0.f; }
#pragma unroll 1
        for (int T = 0; T < ntile; ++T) { {
            load_k<64>(kA, kcb + (size_t)(32 * T) * 64, 64, r, h);
            load_v<64>(vA, vcb + 32 * T, 128, r, h);
            f32x16 s = qk_mm<64>(kA, qf);
#pragma unroll
            for (int i = 0; i < 16; ++i) { const int c = 32 * T + crow(i, h); const bool valid = (c < NCMP) && (16 * c + 31 <= t); s[i] = valid ? __builtin_amdgcn_exp2f(s[i] * (0.125f * L2E) - tm) * inv : 0.f; }
#pragma unroll
            for (int j = 0; j < 4; ++j) { const int n = 2 * (4 * T + j) + h; ownl[n] += (s[4 * j] + s[4 * j + 1]) + (s[4 * j + 2] + 0.5f * s[4 * j + 3]); spll[n] += 0.5f * s[4 * j + 3]; }
            pv_mm<64>(o, vA, s); }
            __builtin_amdgcn_sched_barrier(0);
        }
        const float g0 = sigmoidf_(bf2f(PJ[row * PJW + C_GATE + head * 3 + 0]));
#pragma unroll
        for (int i = 0; i < 16; ++i) { o[0][i] *= g0; o[1][i] *= g0; }
        store_o<64>(OCB + row * 512 + head * 64, o, h);
        __builtin_amdgcn_sched_barrier(0);
    }
    __builtin_amdgcn_wave_barrier();
    float ev[16], od[16];
#pragma unroll
    for (int m = 0; m < 16; ++m) { ev[m] = ownl[2 * m] + (m > 0 ? spll[m > 0 ? 2 * m - 1 : 0] : 0.f); od[m] = ownl[2 * m + 1] + spll[2 * m]; }
    __builtin_amdgcn_wave_barrier();
    const int cur = t >> 6;
#pragma unroll
    for (int m = 0; m < 16; ++m) {
        { const int n = 2 * m; if (n * 64 > t) ev[m] = -INFINITY; if (n == 0 || n == cur || n == cur - 1) ev[m] = INFINITY; }
        { const int n = 2 * m + 1; if (n * 64 > t) od[m] = -INFINITY; if (n == cur || n == cur - 1) od[m] = INFINITY; }
    }
    unsigned mask = 0u;
#pragma unroll 1
    for (int round = 0; round < 8; ++round) {
        float best = -INFINITY; int bi = -1;
#pragma unroll
        for (int m = 0; m < 16; ++m) { if (ev[m] > best) { best = ev[m]; bi = 2 * m; } if (od[m] > best) { best = od[m]; bi = 2 * m + 1; } }
        if (bi >= 0) mask |= 1u << bi;
#pragma unroll
        for (int m = 0; m < 16; ++m) { if (bi == 2 * m) ev[m] = -INFINITY; if (bi == 2 * m + 1) od[m] = -INFINITY; }
    }
    if (h == 0) SEL[row * 2 + g] = mask;
}

DI void nsa_b_unit(const bf16_t* PJ, const bf16_t* VT, const bf16_t* OCB, const unsigned* SEL, bf16_t* YS, int b, int head, int qt, int r, int h) {
    const int t0 = qt * 32, t = t0 + r, g = head >> 2; const size_t row = (size_t)b * SEQ + t;
    bf16x8 qf[4]; load_q<64>(qf, PJ + row * PJW + C_NQ + head * 64, h);
    const unsigned mask = SEL[row * 2 + g];
    f32x16 o[2], os[2];
#pragma unroll
    for (int i = 0; i < 16; ++i) { o[0][i] = 0.f; o[1][i] = 0.f; }
    float mx = -INFINITY, l = 0.f;
    bf16x8 kA[4], kN[4]; s16x4 vA[2][4];
    {
        unsigned um = 0u;
#pragma unroll 1
        for (int kb = 0; kb < 32; ++kb) if (__any((mask >> kb) & 1u)) um |= 1u << kb;
        unsigned long long tl = 0ull;
#pragma unroll 1
        for (int kb = 0; kb < 32; ++kb) if ((um >> kb) & 1u) tl |= 3ull << (2 * kb);
        tl &= (qt >= 63) ? ~0ull : ((1ull << (qt + 1)) - 1ull);
        const bf16_t* Kb = PJ + (size_t)b * SEQ * PJW + C_KSLC + g * 64; const bf16_t* Vb = VT + (size_t)(R_VSLC + g * 64) * MTOK + (size_t)b * SEQ;
        int kt = tl ? __builtin_ctzll(tl) : 0;
        load_k<64>(kA, Kb + (size_t)(kt * 32) * PJW, PJW, r, h);
#pragma unroll 1
        while (tl) {
            tl &= tl - 1ull; const int ktn = tl ? __builtin_ctzll(tl) : kt; const int k0 = kt * 32;
            load_v<64>(vA, Vb + k0, MTOK, r, h);
            load_k<64>(kN, Kb + (size_t)(ktn * 32) * PJW, PJW, r, h);
            f32x16 s = qk_mm<64>(kA, qf);
            const bool bit = (mask >> (kt >> 1)) & 1u;
            f32x16 wgt, p;
#pragma unroll
            for (int i = 0; i < 16; ++i) { s[i] *= 0.125f * L2E; wgt[i] = (bit && (k0 + crow(i, h)) <= t) ? 1.f : 0.f; }
            float corr; osm(s, wgt, mx, l, p, corr, r, h);
#pragma unroll
            for (int i = 0; i < 16; ++i) { o[0][i] *= corr; o[1][i] *= corr; }
            pv_mm<64>(o, vA, p);
            CPK4(kA, kN); kt = ktn;
        }
    }
    const float g1 = sigmoidf_(bf2f(PJ[row * PJW + C_GATE + head * 3 + 1])), g2 = sigmoidf_(bf2f(PJ[row * PJW + C_GATE + head * 3 + 2]));
    { const float lt = l + xorl(l, r | (h << 5), 32); const float inv = lt > 0.f ? g1 / lt : 0.f;
#pragma unroll
      for (int i = 0; i < 16; ++i) { os[0][i] = o[0][i] * inv; os[1][i] = o[1][i] * inv; o[0][i] = 0.f; o[1][i] = 0.f; } }
    mx = -INFINITY; l = 0.f;
    {
        const bf16_t* Kb = PJ + (size_t)b * SEQ * PJW + C_KWIN + g * 64; const bf16_t* Vb = VT + (size_t)(R_VWIN + g * 64) * MTOK + (size_t)b * SEQ;
        const int kt_lo = (t0 - 512) > 0 ? (t0 - 512) >> 5 : 0;
        load_k<64>(kA, Kb + (size_t)(kt_lo * 32) * PJW, PJW, r, h);
#pragma unroll 1
        for (int kt = kt_lo; kt <= qt; ++kt) {
            const int k0 = kt * 32, kn = (kt < qt ? kt + 1 : qt) * 32;
            load_v<64>(vA, Vb + k0, MTOK, r, h);
            load_k<64>(kN, Kb + (size_t)kn * PJW, PJW, r, h);
            f32x16 s = qk_mm<64>(kA, qf);
            f32x16 wgt, p;
#pragma unroll
            for (int i = 0; i < 16; ++i) { const int dl = t - (k0 + crow(i, h)); s[i] *= 0.125f * L2E; wgt[i] = (dl >= 0 && dl < 512) ? 1.f : 0.f; }
            float corr; osm(s, wgt, mx, l, p, corr, r, h);
#pragma unroll
            for (int i = 0; i < 16; ++i) { o[0][i] *= corr; o[1][i] *= corr; }
            pv_mm<64>(o, vA, p);
            CPK4(kA, kN);
        }
    }
    { const float lt = l + xorl(l, r | (h << 5), 32); const float inv = lt > 0.f ? g2 / lt : 0.f;
      const bf16_t* ocr = OCB + row * 512 + head * 64;
#pragma unroll
      for (int db = 0; db < 2; ++db)
#pragma unroll
          for (int jj = 0; jj < 4; ++jj) { const s16x4 cv = *(const s16x4*)(ocr + 32 * db + 8 * jj + 4 * h);
#pragma unroll
              for (int e = 0; e < 4; ++e) o[db][4 * jj + e] = o[db][4 * jj + e] * inv + os[db][4 * jj + e] + bf2f((bf16_t)cv[e]); } }
    store_o<64>(YS + row * DM + 512 + head * 64, o, h);
}

DI void xatt_unit(const bf16_t* QX, const bf16_t* KX, const bf16_t* KXT, bf16_t* OX, int b, int hd, int qt, int r, int h) {
    const int t = qt * 32 + r; const size_t row = (size_t)b * SEQ + t;
    bf16x8 qf[8]; load_q<128>(qf, QX + row * 512 + hd * 128, h);
    f32x16 o[4];
#pragma unroll
    for (int i = 0; i < 16; ++i) { o[0][i] = 0.f; o[1][i] = 0.f; o[2][i] = 0.f; o[3][i] = 0.f; }
    float mx = -INFINITY, l = 0.f;
    const float sc = 0.08838834764831845f * L2E;
    const bf16_t* Kb = KX + (size_t)b * MEMLEN * 1024 + hd * 128; const bf16_t* Vb = KXT + (size_t)(512 + hd * 128) * 2048 + (size_t)b * MEMLEN;
    bf16x8 kA[8]; s16x4 vA[4][4];
    load_k<128>(kA, Kb, 1024, r, h);
#pragma unroll 1
    for (int kt = 0; kt < MEMLEN / 32; ++kt) {
        const int k0 = kt * 32, kn = (kt < MEMLEN / 32 - 1 ? kt + 1 : kt) * 32;
        load_v<128>(vA, Vb + k0, 2048, r, h);
        f32x16 s = qk_mm<128>(kA, qf);
        load_k<128>(kA, Kb + (size_t)kn * 1024, 1024, r, h);
        f32x16 p, wgt;
#pragma unroll
        for (int i = 0; i < 16; ++i) { s[i] *= sc; wgt[i] = 1.f; }
        float corr; osm(s, wgt, mx, l, p, corr, r, h);
#pragma unroll
        for (int i = 0; i < 16; ++i) { o[0][i] *= corr; o[1][i] *= corr; o[2][i] *= corr; o[3][i] *= corr; }
        pv_mm<128>(o, vA, p);
    }
    const float lt = l + xorl(l, r | (h << 5), 32); const float inv = 1.f / lt;
#pragma unroll
    for (int i = 0; i < 16; ++i) { o[0][i] *= inv; o[1][i] *= inv; o[2][i] *= inv; o[3][i] *= inv; }
    store_o<128>(OX + row * 512 + hd * 128, o, h);
}

constexpr int KP = 72, VP = 68, ABUF = 64 * KP + 64 * VP;
constexpr int AFLAG = 2 * ABUF;
DI f32x16 qk_lds(const bf16_t* Kt, int st, const bf16x8 (&qf)[4], int r, int h) {
    f32x16 s;
#pragma unroll
    for (int i = 0; i < 16; ++i) s[i] = 0.f;
    const bf16_t* kp = Kt + (32 * st + r) * KP + 8 * h;
    bf16x8 kf[4];
#pragma unroll
    for (int kk = 0; kk < 4; ++kk) kf[kk] = *(const bf16x8*)(kp + 16 * kk);
    __builtin_amdgcn_s_setprio(1);
#pragma unroll
    for (int kk = 0; kk < 4; ++kk) s = MFMA32(kf[kk], qf[kk], s);
    __builtin_amdgcn_s_setprio(0);
    return s;
}
DI void pv_lds(f32x16 (&o)[2], const bf16_t* Vt, int st, const f32x16& p, int r, int h) {
    const bf16x8 p0 = pack8<0>(p), p1 = pack8<1>(p);
#pragma unroll
    for (int db = 0; db < 2; ++db) { const bf16_t* vp = Vt + (32 * db + r) * VP + 32 * st + 4 * h;
        const s16x4 a0 = *(const s16x4*)(vp), a1 = *(const s16x4*)(vp + 8), b0 = *(const s16x4*)(vp + 16), b1 = *(const s16x4*)(vp + 24);
        const bf16x8 va0 = __builtin_shufflevector(a0, a1, 0, 1, 2, 3, 4, 5, 6, 7), va1 = __builtin_shufflevector(b0, b1, 0, 1, 2, 3, 4, 5, 6, 7);
        __builtin_amdgcn_s_setprio(1); o[db] = MFMA32(va0, p0, o[db]); o[db] = MFMA32(va1, p1, o[db]); __builtin_amdgcn_s_setprio(0); }
}
enum { AM_DIL = 0, AM_SB = 1, AM_SEL = 2, AM_WIN = 3 };
template <int MODE> DI void attn_block(const bf16_t* Kb, const bf16_t* Vb, bf16_t* lds, const bf16x8 (&qf)[4], const int qb, const int t0, const int t, const unsigned mask,
                                       f32x16 (&o)[2], float& mx, float& l, const int wave, const int r, const int h, const int tid) {
    volatile unsigned* flags = (volatile unsigned*)(lds + AFLAG);
    const int srow = tid >> 3, sc = tid & 7;
    const bf16_t* kg = Kb + (size_t)srow * PJW + sc * 8; const bf16_t* vg = Vb + (size_t)srow * MTOK + sc * 8;
    const int jtop = 4 * qb + 3;
    unsigned tl = 0u;
    if (MODE == AM_SEL) {
        unsigned um = 0u;
#pragma unroll 1
        for (int kb = 0; kb <= jtop; ++kb) if (__any((mask >> kb) & 1u)) um |= 1u << kb;
        if ((tid & 63) == 0) flags[8 + wave] = um;
        __syncthreads();
#pragma unroll
        for (int w = 0; w < 8; ++w) tl |= flags[8 + w];
        tl = __builtin_amdgcn_readfirstlane(tl);
    }
    int j = (MODE == AM_DIL) ? 0 : (MODE == AM_SB) ? jtop : (MODE == AM_WIN) ? (4 * qb - 8 > 0 ? 4 * qb - 8 : 0) : (tl ? __builtin_ctz(tl) : 0);
    bool have = (MODE == AM_SEL) ? (tl != 0u) : true;
    if (MODE == AM_SEL) tl &= tl - 1u;
    u32x4 kreg, vreg;
    if (have) { kreg = *(const u32x4*)(kg + (size_t)(64 * j) * PJW); vreg = *(const u32x4*)(vg + 64 * j); }
    float carry = 0.f; bool wact = true; int it = 0;
#pragma unroll 1
    while (have) {
        bf16_t* B = lds + (it & 1) * ABUF;
        *(u32x4*)(B + srow * KP + sc * 8) = kreg;
        { u32x2* vp = (u32x2*)(B + 64 * KP + srow * VP + sc * 8); u32x2 v0, v1; v0.x = vreg.x; v0.y = vreg.y; v1.x = vreg.z; v1.y = vreg.w; vp[0] = v0; vp[1] = v1; }
        if (MODE == AM_SB) { if ((tid & 63) == 0) flags[(it & 1) * 8 + wave] = wact ? 1u : 0u; }
        __syncthreads();
        if (MODE == AM_SB) { unsigned any = 0u;
#pragma unroll
            for (int w = 0; w < 8; ++w) any |= flags[(it & 1) * 8 + w];
            if (!__builtin_amdgcn_readfirstlane(any)) break; }
        int jn = j; bool have_n;
        if (MODE == AM_DIL || MODE == AM_WIN) { jn = j + 1; have_n = jn <= jtop; }
        else if (MODE == AM_SB) { jn = j - 1; have_n = jn >= 0; }
        else { have_n = (tl != 0u); if (have_n) { jn = __builtin_ctz(tl); tl &= tl - 1u; } }
        if (have_n) { kreg = *(const u32x4*)(kg + (size_t)(64 * jn) * PJW); vreg = *(const u32x4*)(vg + 64 * jn); }
        const bf16_t* Kt = B; const bf16_t* Vt = B + 64 * KP;
#pragma unroll
        for (int sti = 0; sti < 2; ++sti) {
            const int st = (MODE == AM_SB) ? 1 - sti : sti; const int k0 = 64 * j + 32 * st;
            bool need = k0 <= t0 + 31;
            if (MODE == AM_SB) need = need && wact;
            if (MODE == AM_WIN) need = need && (k0 + 31 >= t0 - 511);
            const bool bit = (MODE == AM_SEL) ? ((mask >> j) & 1u) : true;
            if (MODE == AM_SEL) need = need && __any(bit ? 1 : 0);
            if (need) {
                f32x16 s = qk_lds(Kt, st, qf, r, h);
                if (MODE == AM_SB) {
                    f32x16 lfm, ls;
#pragma unroll
                    for (int i = 0; i < 16; ++i) { const float z = s[i] * 0.125f; const float sp = fmaxf(z, 0.f) + __logf(1.f + __expf(-fabsf(z)));
                        const bool valid = (k0 + crow(i, h)) < t; lfm[i] = valid ? -sp : 0.f; ls[i] = valid ? (z - sp) : -INFINITY; }
                    float G[4], Gp[4];
#pragma unroll
                    for (int jj = 0; jj < 4; ++jj) { G[jj] = (lfm[4 * jj] + lfm[4 * jj + 1]) + (lfm[4 * jj + 2] + lfm[4 * jj + 3]); Gp[jj] = xorl(G[jj], r | (h << 5), 32); }
                    float run = carry; f32x16 w;
#pragma unroll
                    for (int jj = 3; jj >= 0; --jj) { const float gh1 = h ? G[jj] : Gp[jj], gh0 = h ? Gp[jj] : G[jj]; float a = run + (h ? 0.f : gh1);
                        w[4 * jj + 3] = __expf(ls[4 * jj + 3] + a); a += lfm[4 * jj + 3];
                        w[4 * jj + 2] = __expf(ls[4 * jj + 2] + a); a += lfm[4 * jj + 2];
                        w[4 * jj + 1] = __expf(ls[4 * jj + 1] + a); a += lfm[4 * jj + 1];
                        w[4 * jj + 0] = __expf(ls[4 * jj + 0] + a);
                        run += gh1 + gh0; }
                    carry = run;
                    pv_lds(o, Vt, st, w, r, h);
                    wact = !__all(carry < -110.f);
                } else {
                    f32x16 p; float corr;
                    if (MODE == AM_DIL) {
                        const int base = t - k0 - 4 * h; const int dmin = t0 - (k0 + 31), dmax = t0 + 31 - k0;
                        if (dmin > 512) {
#pragma unroll
                            for (int i = 0; i < 16; ++i) { const int dl = base - ((i & 3) + 8 * (i >> 2)); s[i] = ((dl & 15) == 0) ? s[i] * (0.125f * L2E) : -INFINITY; }
                        } else if (dmin > 128 && dmax <= 512) {
#pragma unroll
                            for (int i = 0; i < 16; ++i) { const int dl = base - ((i & 3) + 8 * (i >> 2)); s[i] = ((dl & 3) == 0) ? fmaf(s[i], 0.125f * L2E, ((dl & 15) == 0) ? 1.f : 0.f) : -INFINITY; }
                        } else if (dmin >= 0 && dmax <= 128) {
#pragma unroll
                            for (int i = 0; i < 16; ++i) { const int dl = base - ((i & 3) + 8 * (i >> 2)); s[i] = fmaf(s[i], 0.125f * L2E, ((dl & 15) == 0) ? 1.5849625007f : (((dl & 3) == 0) ? 1.f : 0.f)); }
                        } else {
#pragma unroll
                            for (int i = 0; i < 16; ++i) { const int dl = base - ((i & 3) + 8 * (i >> 2));
                                const int m = (dl <= 128 ? 1 : 0) + (((dl & 3) == 0 && dl <= 512) ? 1 : 0) + (((dl & 15) == 0) ? 1 : 0);
                                const float lm = m >= 3 ? 1.5849625007f : (m == 2 ? 1.f : 0.f);
                                s[i] = (dl >= 0 && m > 0) ? fmaf(s[i], 0.125f * L2E, lm) : -INFINITY; }
                        }
                        osm_b(s, mx, l, p, corr, r, h);
                    } else {
                        const int base = t - k0 - 4 * h;
#pragma unroll
                        for (int i = 0; i < 16; ++i) { const int dl = base - ((i & 3) + 8 * (i >> 2));
                            const bool valid = (MODE == AM_WIN) ? ((unsigned)dl < 512u) : (bit && dl >= 0);
                            s[i] = valid ? s[i] * (0.125f * L2E) : -INFINITY; }
                        osm_b(s, mx, l, p, corr, r, h);
                    }
                    if (!__all(corr == 1.f)) {
#pragma unroll
                        for (int i = 0; i < 16; ++i) { o[0][i] *= corr; o[1][i] *= corr; } }
                    pv_lds(o, Vt, st, p, r, h);
                }
            }
        }
        j = jn; have = have_n; ++it;
    }
    __syncthreads();
}

constexpr int XKP = 136, XVP = 68, XBUF = 64 * XKP + 128 * XVP;
DI void xatt_block(const bf16_t* QX, const bf16_t* KX, const bf16_t* KXT, bf16_t* OX, bf16_t* lds, int b, int hd, int qb, int wave, int r, int h, int tid) {
    const int t = qb * 256 + wave * 32 + r; const size_t row = (size_t)b * SEQ + t;
    bf16x8 qf[8]; load_q<128>(qf, QX + row * 512 + hd * 128, h);
    f32x16 o[4];
#pragma unroll
    for (int i = 0; i < 16; ++i) { o[0][i] = 0.f; o[1][i] = 0.f; o[2][i] = 0.f; o[3][i] = 0.f; }
    float mx = -INFINITY, l = 0.f;
    const float sc_ = 0.08838834764831845f * L2E;
    const int srow = tid >> 3, sc = tid & 7;
    const bf16_t* kg = KX + ((size_t)b * MEMLEN + srow) * 1024 + hd * 128 + sc * 8; const bf16_t* vg = KXT + (size_t)(512 + hd * 128 + srow) * 2048 + (size_t)b * MEMLEN + sc * 8;
    u32x4 k0r, k1r, v0r, v1r;
    k0r = *(const u32x4*)(kg); k1r = *(const u32x4*)(kg + 64); v0r = *(const u32x4*)(vg); v1r = *(const u32x4*)(vg + (size_t)64 * 2048);
#pragma unroll 1
    for (int j = 0; j < 4; ++j) {
        bf16_t* B = lds + (j & 1) * XBUF;
        *(u32x4*)(B + srow * XKP + sc * 8) = k0r; *(u32x4*)(B + srow * XKP + sc * 8 + 64) = k1r;
        { u32x2* vp = (u32x2*)(B + 64 * XKP + srow * XVP + sc * 8); u32x2 a, c; a.x = v0r.x; a.y = v0r.y; c.x = v0r.z; c.y = v0r.w; vp[0] = a; vp[1] = c; }
        { u32x2* vp = (u32x2*)(B + 64 * XKP + (srow + 64) * XVP + sc * 8); u32x2 a, c; a.x = v1r.x; a.y = v1r.y; c.x = v1r.z; c.y = v1r.w; vp[0] = a; vp[1] = c; }
        __syncthreads();
        if (j < 3) { const bf16_t* kn = kg + (size_t)(64 * (j + 1)) * 1024; const bf16_t* vn = vg + 64 * (j + 1);
            k0r = *(const u32x4*)(kn); k1r = *(const u32x4*)(kn + 64); v0r = *(const u32x4*)(vn); v1r = *(const u32x4*)(vn + (size_t)64 * 2048); }
        const bf16_t* Kt = B; const bf16_t* Vt = B + 64 * XKP;
#pragma unroll
        for (int st = 0; st < 2; ++st) {
            f32x16 s;
#pragma unroll
            for (int i = 0; i < 16; ++i) s[i] = 0.f;
            const bf16_t* kp = Kt + (32 * st + r) * XKP + 8 * h;
#pragma unroll
            for (int kk = 0; kk < 8; ++kk) { const bf16x8 kf = *(const bf16x8*)(kp + 16 * kk); s = MFMA32(kf, qf[kk], s); }
            f32x16 p;
#pragma unroll
            for (int i = 0; i < 16; ++i) s[i] *= sc_;
            float corr; osm_b(s, mx, l, p, corr, r, h);
            if (!__all(corr == 1.f)) {
#pragma unroll
                for (int i = 0; i < 16; ++i) { o[0][i] *= corr; o[1][i] *= corr; o[2][i] *= corr; o[3][i] *= corr; } }
            const bf16x8 p0 = pack8<0>(p), p1 = pack8<1>(p);
#pragma unroll
            for (int db = 0; db < 4; ++db) { const bf16_t* vp = Vt + (32 * db + r) * XVP + 32 * st + 4 * h;
                const s16x4 a0 = *(const s16x4*)(vp), a1 = *(const s16x4*)(vp + 8), b0 = *(const s16x4*)(vp + 16), b1 = *(const s16x4*)(vp + 24);
                const bf16x8 va0 = __builtin_shufflevector(a0, a1, 0, 1, 2, 3, 4, 5, 6, 7), va1 = __builtin_shufflevector(b0, b1, 0, 1, 2, 3, 4, 5, 6, 7);
                o[db] = MFMA32(va0, p0, o[db]); o[db] = MFMA32(va1, p1, o[db]); }
        }
    }
    __syncthreads();
    const float lt = l + xorl(l, r | (h << 5), 32); const float inv = 1.f / lt;
#pragma unroll
    for (int i = 0; i < 16; ++i) { o[0][i] *= inv; o[1][i] *= inv; o[2][i] *= inv; o[3][i] *= inv; }
    store_o<128>(OX + row * 512 + hd * 128, o, h);
}

DI void conv_tile(const float* W, int ld, int src_col0, int nvalid, bf16_t* WT, int ldt, int dst_row0, int k0, float* scr, const int lane) {
    const float* src = W + (size_t)k0 * ld + src_col0 + 2 * lane;
    f32x2 tv[32];
#pragma unroll
    for (int k = 0; k < 32; ++k) tv[k] = __builtin_nontemporal_load((const f32x2*)(src + (size_t)k * ld));
    const bool ok0 = 2 * lane < nvalid, ok1 = 2 * lane + 1 < nvalid;
#pragma unroll
    for (int k = 0; k < 32; ++k) { scr[k * 129 + 2 * lane] = ok0 ? tv[k][0] : 0.f; scr[k * 129 + 2 * lane + 1] = ok1 ? tv[k][1] : 0.f; }
    __builtin_amdgcn_wave_barrier();
    const int kg = lane & 3;
#pragma unroll
    for (int ps = 0; ps < 8; ++ps) { const int n2 = (lane >> 2) + 16 * ps; const float* s = scr + (kg * 8) * 129 + n2;
      u32x4 o; o.x = pk2(s[0], s[129]); o.y = pk2(s[2 * 129], s[3 * 129]); o.z = pk2(s[4 * 129], s[5 * 129]); o.w = pk2(s[6 * 129], s[7 * 129]);
      *(u32x4*)(WT + (size_t)(dst_row0 + n2) * ldt + k0 + kg * 8) = o; }
    __builtin_amdgcn_wave_barrier();
}
DI void wconv_phase(const Params& p, unsigned char* ws, int L, float* wscr, const int lane, const int part, const int w0, const int nw, const int lo, const int hi) {
    constexpr int T0 = 60 * 32, T1 = T0 + 20 * 32, T2 = T1 + 32 * 32, T3 = T2 + 8 * 32, T4 = T3 + 16 * 32, T5 = T4 + 32 * 8, T6 = T5 + 176 * 32, T7 = T6 + 32 * 88, T8 = T7 + 8 * 8, T9 = T8 + 4 * 32;
    const int nit = part == 1 ? (T6 - T5) : part == 2 ? (T7 - T6) : (T5 + (T9 - T7));
    const int nend = hi < nit ? hi : nit;
    for (int it0 = lo + w0; it0 < nend; it0 += nw) {
        const int it = part == 1 ? (it0 + T5) : part == 2 ? (it0 + T6) : (it0 < T5 ? it0 : it0 + (T7 - T5));
        const float* W; int ld, col0, nvalid = 128, j, kt, ldt; bf16_t* WT;
        if (it < T0) { const int x = it; j = 2 * (x / (2 * 32)); kt = x % (2 * 32); W = p.in[I_WIN] + (size_t)L * DM * INW; ld = INW; WT = (bf16_t*)(ws + WS_WIN); ldt = DM;
            if (j < 8) col0 = 64 * j; else if (j < 16) col0 = 512 + 64 * (j - 8); else if (j < 18) col0 = 1024 + 64 * (j - 16); else if (j < 20) col0 = 1152 + 64 * (j - 18);
            else if (j < 22) col0 = 1280 + 64 * (j - 20); else if (j < 24) col0 = 1536 + 64 * (j - 22); else if (j < 32) col0 = 1816 + 64 * (j - 24); else if (j < 40) col0 = 2328 + 64 * (j - 32);
            else if (j < 48) col0 = 3352 + 64 * (j - 40); else if (j < 56) col0 = 3864 + 64 * (j - 48); else if (j == 56) { col0 = 1792; nvalid = 24; } else { col0 = 0; nvalid = 0; } }
        else if (it < T1) { const int x = it - T0; j = 2 * (x / (2 * 32)); kt = x % (2 * 32); W = p.in[I_WIN] + (size_t)L * DM * INW; ld = INW; WT = (bf16_t*)(ws + WS_WINV); ldt = DM;
            if (j < 2) col0 = 1408 + 64 * j; else if (j < 4) col0 = 1664 + 64 * (j - 2); else if (j < 12) col0 = 2840 + 64 * (j - 4); else col0 = 4376 + 64 * (j - 12); }
        else if (it < T2) { const int x = it - T1; j = 2 * (x / (2 * 32)); kt = x % (2 * 32); W = p.in[I_WOUT] + (size_t)L * DM * DM; ld = DM; WT = (bf16_t*)(ws + WS_WOUT); ldt = DM; col0 = 64 * j; }
        else if (it < T3) { const int x = it - T2; j = 2 * (x / (2 * 32)); kt = x % (2 * 32); W = p.in[I_WQ] + (size_t)L * DM * 512; ld = 512; WT = (bf16_t*)(ws + WS_WQ); ldt = DM; col0 = 64 * j; }
        else if (it < T4) { const int x = it - T3; j = 2 * (x / (2 * 32)); kt = x % (2 * 32); W = p.in[I_WKV] + (size_t)L * DM * 1024; ld = 1024; WT = (bf16_t*)(ws + WS_WKV); ldt = DM; col0 = 64 * j; }
        else if (it < T5) { const int x = it - T4; j = 2 * (x / (2 * 8)); kt = x % (2 * 8); W = p.in[I_WO] + (size_t)L * 512 * DM; ld = DM; WT = (bf16_t*)(ws + WS_WO); ldt = 512; col0 = 64 * j; }
        else if (it < T6) { const int x = it - T5; j = 2 * (x / (2 * 32)); kt = x % (2 * 32); const int pn = j >> 2, q = j & 3; W = (q < 2 ? p.in[I_FG] : p.in[I_FU]) + (size_t)L * DM * FFH; ld = FFH; WT = (bf16_t*)(ws + WS_WGU); ldt = DM; col0 = 128 * pn + 64 * (q & 1); }
        else if (it < T7) { const int x = it - T6; j = 2 * (x / (2 * 88)); kt = x % (2 * 88); W = p.in[I_FD] + (size_t)L * FFH * DM; ld = DM; WT = (bf16_t*)(ws + WS_WD); ldt = FFH; col0 = 64 * j; }
        else if (it < T8) { const int x = it - T7; j = 2 * (x / (2 * 8)); kt = x % (2 * 8); W = p.in[I_WGLU] + (size_t)L * 512 * 512; ld = 512; WT = (bf16_t*)(ws + WS_WGLU); ldt = 512; col0 = 64 * j; }
        else { const int x = it - T8; j = 2 * (x / (2 * 32)); kt = x % (2 * 32); W = p.in[I_CW1] + ((size_t)L * 2 + (j >> 1)) * DM * 128; ld = 128; WT = (bf16_t*)(ws + WS_WC1); ldt = DM; col0 = 64 * (j & 1); }
        conv_tile(W, ld, col0, nvalid, WT, ldt, 64 * j, 32 * kt, wscr, lane);
    }
}
DI void ln_row(const float* src, const float* g, const float* bsh, float* dstf, bf16_t* dstb, float* dsto, int lane) {
    f32x4 v[8]; float s = 0.f;
#pragma unroll
    for (int j = 0; j < 8; ++j) { v[j] = *(const f32x4*)(src + 256 * j + 4 * lane); s += (v[j][0] + v[j][1]) + (v[j][2] + v[j][3]); }
    const float mean = wave_sum(s, lane) * (1.f / DM); float s2 = 0.f;
#pragma unroll
    for (int j = 0; j < 8; ++j) { v[j] = v[j] - mean; s2 += (v[j][0] * v[j][0] + v[j][1] * v[j][1]) + (v[j][2] * v[j][2] + v[j][3] * v[j][3]); }
    const float rstd = 1.f / sqrtf(wave_sum(s2, lane) * (1.f / DM) + LN_EPS);
#pragma unroll
    for (int j = 0; j < 8; ++j) { const f32x4 gg = *(const f32x4*)(g + 256 * j + 4 * lane), bb = *(const f32x4*)(bsh + 256 * j + 4 * lane);
        f32x4 y = v[j] * rstd * gg + bb;
        if (dstf) *(f32x4*)(dstf + 256 * j + 4 * lane) = y;
        if (dsto) *(f32x4*)(dsto + 256 * j + 4 * lane) = y;
        u32x2 w; w.x = pk2(y[0], y[1]); w.y = pk2(y[2], y[3]); *(u32x2*)(dstb + 256 * j + 4 * lane) = w; }
}
template <int NR> DI void ln_rows(const float* src, size_t rstride, const float* g, const float* bsh, bf16_t* dstb, float* dsto, int lane) {
    f32x4 v[NR][8]; float s[NR], s2[NR];
#pragma unroll
    for (int q = 0; q < NR; ++q)
#pragma unroll
        for (int j = 0; j < 8; ++j) v[q][j] = __builtin_nontemporal_load((const f32x4*)(src + q * rstride + 256 * j + 4 * lane));
#pragma unroll
    for (int q = 0; q < NR; ++q) { s[q] = 0.f;
#pragma unroll
        for (int j = 0; j < 8; ++j) s[q] += (v[q][j][0] + v[q][j][1]) + (v[q][j][2] + v[q][j][3]); }
#pragma unroll
    for (int o = 1; o < 64; o <<= 1)
#pragma unroll
        for (int q = 0; q < NR; ++q) s[q] += xorl(s[q], lane, o);
#pragma unroll
    for (int q = 0; q < NR; ++q) { const float mean = s[q] * (1.f / DM); s2[q] = 0.f;
#pragma unroll
        for (int j = 0; j < 8; ++j) { v[q][j] = v[q][j] - mean; s2[q] += (v[q][j][0] * v[q][j][0] + v[q][j][1] * v[q][j][1]) + (v[q][j][2] * v[q][j][2] + v[q][j][3] * v[q][j][3]); } }
#pragma unroll
    for (int o = 1; o < 64; o <<= 1)
#pragma unroll
        for (int q = 0; q < NR; ++q) s2[q] += xorl(s2[q], lane, o);
#pragma unroll
    for (int j = 0; j < 8; ++j) { const f32x4 gg = *(const f32x4*)(g + 256 * j + 4 * lane), bb = *(const f32x4*)(bsh + 256 * j + 4 * lane);
#pragma unroll
        for (int q = 0; q < NR; ++q) { const float rstd = 1.f / sqrtf(s2[q] * (1.f / DM) + LN_EPS); const f32x4 y = v[q][j] * rstd * gg + bb;
            if (dsto) *(f32x4*)(dsto + q * rstride + 256 * j + 4 * lane) = y;
            u32x2 w; w.x = pk2(y[0], y[1]); w.y = pk2(y[2], y[3]); *(u32x2*)(dstb + q * rstride + 256 * j + 4 * lane) = w; } }
}

template <int NR> DI void ln_rows_b(const bf16_t* src, size_t rstride, const float* g, const float* bsh, bf16_t* dstb, float* dsto, int lane) {
    bf16x8 raw[NR][4]; float s[NR], s2[NR];
#pragma unroll
    for (int q = 0; q < NR; ++q)
#pragma unroll
        for (int j = 0; j < 4; ++j) raw[q][j] = *(const bf16x8*)(src + q * rstride + 512 * j + 8 * lane);
#pragma unroll
    for (int q = 0; q < NR; ++q) { s[q] = 0.f;
#pragma unroll
        for (int j = 0; j < 4; ++j)
#pragma unroll
            for (int e = 0; e < 8; ++e) s[q] += bf2f((bf16_t)raw[q][j][e]); }
#pragma unroll
    for (int o = 1; o < 64; o <<= 1)
#pragma unroll
        for (int q = 0; q < NR; ++q) s[q] += xorl(s[q], lane, o);
#pragma unroll
    for (int q = 0; q < NR; ++q) { const float mean = s[q] * (1.f / DM); s[q] = mean; s2[q] = 0.f;
#pragma unroll
        for (int j = 0; j < 4; ++j)
#pragma unroll
            for (int e = 0; e < 8; ++e) { const float d = bf2f((bf16_t)raw[q][j][e]) - mean; s2[q] += d * d; } }
#pragma unroll
    for (int o = 1; o < 64; o <<= 1)
#pragma unroll
        for (int q = 0; q < NR; ++q) s2[q] += xorl(s2[q], lane, o);
#pragma unroll
    for (int j = 0; j < 4; ++j) { const float* gp = g + 512 * j + 8 * lane; const float* bp = bsh + 512 * j + 8 * lane;
        const f32x4 g0 = *(const f32x4*)gp, g1 = *(const f32x4*)(gp + 4), b0 = *(const f32x4*)bp, b1 = *(const f32x4*)(bp + 4);
#pragma unroll
        for (int q = 0; q < NR; ++q) { const float rstd = 1.f / sqrtf(s2[q] * (1.f / DM) + LN_EPS), mean = s[q]; f32x4 y0, y1;
#pragma unroll
            for (int e = 0; e < 4; ++e) { y0[e] = (bf2f((bf16_t)raw[q][j][e]) - mean) * rstd * g0[e] + b0[e]; y1[e] = (bf2f((bf16_t)raw[q][j][4 + e]) - mean) * rstd * g1[e] + b1[e]; }
            if (dsto) { __builtin_nontemporal_store(y0, (f32x4*)(dsto + q * rstride + 512 * j + 8 * lane)); __builtin_nontemporal_store(y1, (f32x4*)(dsto + q * rstride + 512 * j + 8 * lane + 4)); }
            u32x4 w; w.x = pk2(y0[0], y0[1]); w.y = pk2(y0[2], y0[3]); w.z = pk2(y1[0], y1[1]); w.w = pk2(y1[2], y1[3]);
            if (dstb) *(u32x4*)(dstb + q * rstride + 512 * j + 8 * lane) = w; } }
}

#define XB_TMO      128
#define XB_XCNT(j)  (256  + 64 * (j))
#define XB_XSUB(j)  (1280 + 64 * (j))
#define XB_XGEN(j)  (2304 + 64 * (j))
#define XB_TOP      3328
#define XB_TOPGEN   3392
#define XCD_BAR_WORDS 3456
#define XB_SPIN_CAP (1u << 18)

__device__ __forceinline__ unsigned xb_ld(unsigned* p)              { return __hip_atomic_load(p, __ATOMIC_RELAXED, __HIP_MEMORY_SCOPE_AGENT); }
__device__ __forceinline__ unsigned xb_add(unsigned* p, unsigned v) { return __hip_atomic_fetch_add(p, v, __ATOMIC_RELAXED, __HIP_MEMORY_SCOPE_AGENT); }
__device__ __forceinline__ unsigned xb_xcc_id() { return (unsigned)__builtin_amdgcn_s_getreg((3 << 11) | 20) & 0xFu; }
#define XB_SPIN(cond, bar) do { unsigned _sp = 0; while (cond) { __builtin_amdgcn_s_sleep(1); \
    if ((++_sp & 255u) == 0u) { if (xb_ld(&(bar)[XB_TMO])) break; if (_sp > XB_SPIN_CAP) { atomicAdd(&(bar)[XB_TMO], 1u); break; } } } } while (0)

struct XcdBarrier {
    unsigned* bar; unsigned x;
    volatile LAS unsigned* st;
};

__device__ __forceinline__ XcdBarrier xcd_barrier_post(unsigned* bar, volatile LAS unsigned* st) {
    XcdBarrier b; b.bar = bar; b.x = xb_xcc_id(); b.st = st;
    if (threadIdx.x == 0) (void)xb_add(&bar[XB_XCNT(b.x)], 1u);
    return b;
}
__device__ __forceinline__ void xcd_barrier_complete(unsigned* bar, unsigned x, unsigned& nloc, unsigned& nx) {
    const unsigned G = gridDim.x * gridDim.y * gridDim.z;
    unsigned sum, cnt, mine, sp = 0u;
    for (;;) {
        sum = 0u; cnt = 0u; mine = 0u;
#pragma unroll
        for (unsigned j = 0; j < 16; ++j) { const unsigned c = xb_ld(&bar[XB_XCNT(j)]); sum += c; cnt += (c > 0u) ? 1u : 0u; mine = (j == x) ? c : mine; }
        if (sum == G) break;
        __builtin_amdgcn_s_sleep(1);
        if ((++sp & 255u) == 0u) { if (xb_ld(&bar[XB_TMO])) break; if (sp > XB_SPIN_CAP) { atomicAdd(&bar[XB_TMO], 1u); break; } }
    }
    nloc = mine > 0u ? mine : 1u; nx = cnt > 0u ? cnt : 1u;
}

__device__ __forceinline__ void xcd_barrier(const XcdBarrier& b) {
    asm volatile("s_waitcnt vmcnt(0)" ::: "memory");
    __syncthreads();
    if (threadIdx.x == 0) {
        unsigned* bar = b.bar;
        __builtin_amdgcn_s_waitcnt(0);
        unsigned nloc = b.st[0], nx = b.st[1];
        if (nloc == 0u) { xcd_barrier_complete(bar, b.x, nloc, nx); b.st[0] = nloc; b.st[1] = nx; }
        const unsigned old = xb_add(&bar[XB_XSUB(b.x)], 1u);
        const unsigned gen = old / nloc;
        if (old + 1u == (gen + 1u) * nloc) {
            __builtin_amdgcn_fence(__ATOMIC_RELEASE, "agent");
            asm volatile("s_waitcnt vmcnt(0)" ::: "memory");
            const unsigned og = xb_add(&bar[XB_TOP], 1u);
            const unsigned tg = og / nx;
            if (og + 1u == (tg + 1u) * nx) xb_add(&bar[XB_TOPGEN], 1u);
            else XB_SPIN(xb_ld(&bar[XB_TOPGEN]) == tg, bar);
            __builtin_amdgcn_fence(__ATOMIC_ACQUIRE, "agent");
            xb_add(&bar[XB_XGEN(b.x)], 1u);
            asm volatile("s_waitcnt vmcnt(0)" ::: "memory");
        } else {
            XB_SPIN(xb_ld(&bar[XB_XGEN(b.x)]) == gen, bar);
            __builtin_amdgcn_fence(__ATOMIC_ACQUIRE, "agent");
            asm volatile("s_waitcnt vmcnt(0)" ::: "memory");
        }
    }
    __syncthreads();
}

constexpr int GU_EARLY = 960;
#ifndef MK_REP_SUB
#define MK_REP_SUB 0
#endif
#ifndef MK_REP_MASK
#define MK_REP_MASK 0
#endif
constexpr int PH_PER_LAYER = 20, N_PHASES = PH_PER_LAYER * DEPTH;

__global__ void __launch_bounds__(512, 2) mk_fwd(Params p, int ph_lo, int ph_hi) {
    extern __shared__ __attribute__((aligned(16))) unsigned char lds_raw[];
    LAS unsigned char* lds = (LAS unsigned char*)lds_raw;
    float* scr = (float*)lds_raw;
    cg::grid_group grid = cg::this_grid();
    const int wave0 = __builtin_amdgcn_readfirstlane(threadIdx.x >> 6);
    { volatile LAS unsigned* st0 = (volatile LAS unsigned*)(lds + LDS_BYTES - 128); if (threadIdx.x < 2) st0[threadIdx.x] = 0u; __syncthreads(); }
    const XcdBarrier xbar = xcd_barrier_post((unsigned*)(p.ws + WS_BAR), (volatile LAS unsigned*)(lds + LDS_BYTES - 128));
#pragma unroll 1
    for (int ph2 = 2 * ph_lo; ph2 < 2 * ph_hi; ++ph2) {
        const int ph = ph2 >> 1;
        const int L = ph / PH_PER_LAYER, step = ph % PH_PER_LAYER;
        const int k = step <= 3 ? step : step <= 6 ? step + 13 : step - 3;
        const bool sync_after = !(step >= 3 && step <= 5);
        if ((ph2 & 1) && !((MK_REP_MASK >> k) & 1)) continue;
        int lane_; asm volatile("v_mbcnt_lo_u32_b32 %0, -1, 0\n\tv_mbcnt_hi_u32_b32 %0, -1, %0" : "=v"(lane_));
        const int tid = wave0 * 64 + lane_;
        unsigned char* ws = p.ws; asm volatile("" : "+s"(ws));
        float* scr = (float*)lds_raw;
        const int lane = tid & 63, wave = __builtin_amdgcn_readfirstlane(tid >> 6);
        const int gw = blockIdx.x * 8 + wave, NGW = gridDim.x * 8;
        const int r = lane & 31, h = lane >> 5;
        float* HF = (float*)(ws + WS_HF); bf16_t* HB = (bf16_t*)(ws + WS_HB); bf16_t* PJ = (bf16_t*)(ws + WS_PJ); bf16_t* VT = (bf16_t*)(ws + WS_VT);
        bf16_t* YS = (bf16_t*)(ws + WS_YS); bf16_t* GA = (bf16_t*)(ws + WS_GA); bf16_t* OCB = (bf16_t*)(ws + WS_OCB); float* ROPE = (float*)(ws + WS_ROPE);
        bf16_t* CMPA = (bf16_t*)(ws + WS_CMPA); bf16_t* HC = (bf16_t*)(ws + WS_HC); bf16_t* KC = (bf16_t*)(ws + WS_KC); bf16_t* VCT = (bf16_t*)(ws + WS_VCT);
        unsigned* SEL = (unsigned*)(ws + WS_SEL); f32x2* S5E = (f32x2*)(ws + WS_S5E); bf16_t* MEMB = (bf16_t*)(ws + WS_MEMB);
        bf16_t* QX = (bf16_t*)(ws + WS_QX); bf16_t* OX = (bf16_t*)(ws + WS_OX); bf16_t* KX = (bf16_t*)(ws + WS_KX); bf16_t* KXT = (bf16_t*)(ws + WS_KXT);
        {
            const int ng = (k == 1) ? 2 : (k == 10) ? 3 : (k == 3 || k == 4 || k == 8 || k == 12 || k == 14 || k == 15) ? 1 : 0;
            for (int gi = 0; gi < ng; ++gi) {
                size_t oA = 0, oB = 0, oO = 0; int gM = 0, gN = 0, gK = DM, gmode = 0, gld = 0, grot = 0;
                if (k == 1) { if (gi == 0) { oA = WS_HB; oB = WS_WIN; gM = MTOK; gN = PJW; oO = WS_PJ; gld = PJW; } else { oA = WS_WINV; oB = WS_HB; gM = VTR; gN = MTOK; oO = WS_VT; gld = MTOK; grot = 64; } }
                else if (k == 3) { oA = WS_CMPA; oB = WS_WC1; gM = 4096; gN = 256; gmode = 1; oO = WS_HC; gld = 256; }
                else if (k == 4) { oA = WS_GA; oB = WS_WGLU; gM = MTOK; gN = 512; gK = 512; gmode = 4; oO = WS_YS; gld = DM; }
                else if (k == 8) { oA = WS_YS; oB = WS_WOUT; gM = MTOK; gN = DM; gmode = 2; oO = WS_HF; gld = DM; }
                else if (k == 10) { if (gi == 0) { oA = WS_HB; oB = WS_WQ; gM = MTOK; gN = 512; oO = WS_QX; gld = 512; } else if (gi == 1) { oA = WS_MEMB; oB = WS_WKV; gM = 2048; gN = 1024; oO = WS_KX; gld = 1024; grot = 128; } else { oA = WS_WKV; oB = WS_MEMB; gM = 1024; gN = 2048; oO = WS_KXT; gld = 2048; grot = 96; } }
                else if (k == 12) { oA = WS_OX; oB = WS_WO; gM = MTOK; gN = DM; gK = 512; gmode = 2; oO = WS_HF; gld = DM; }
                else if (k == 14) { oA = WS_HB; oB = WS_WGU; gM = MTOK; gN = 2 * FFH; gmode = 3; oO = WS_ACT; gld = FFH; }
                else { oA = WS_ACT; oB = WS_WD; gM = MTOK; gN = DM; gK = FFH; gmode = 2; oO = WS_HF; gld = DM; }
                pg8::Gemm g{(const bf16_t*)(ws + oA), (const bf16_t*)(ws + oB), gM, gN, gK};
                pg8::StaticOrder S; S.init(gM, gN, (int)gridDim.x, (int)((blockIdx.x + grot) % gridDim.x));
                pg8::EpiAny E{gmode, (void*)(ws + oO), gld, (const void*)(ws + (gmode == 2 ? WS_HB : WS_GA)), (const void*)(p.in[I_BGLU] + L * 512)};
                pg8::gemm_phase<pg8::EpiAny, pg8::StaticOrder, true, true>(lds, g, S, E, tid);
                __syncthreads();
            }
        }

        if (k == 0) {
            wconv_phase(p, ws, L, scr + wave * (64 * 65), lane, 0, gw, NGW, 0, 1 << 30);
            if (L == 0) {
                for (int i = blockIdx.x * 512 + tid; i < 2048 * 32; i += gridDim.x * 512) { const int pos = i >> 5, f = i & 31;
                    const float invf = powf(10000.f, -(float)f / 32.f); float sn, cs; sincos_acc((float)pos * invf, sn, cs); ROPE[2 * i] = cs; ROPE[2 * i + 1] = sn; }
                for (int m = gw; m < MTOK / 4; m += NGW) ln_rows<4>(p.in[I_X] + (size_t)m * DM, (size_t)(MTOK / 4) * DM, p.in[I_LNG], p.in[I_LNB], HB + (size_t)m * DM, nullptr, lane);
                for (size_t i = (size_t)blockIdx.x * 512 + tid; i < (size_t)2048 * DM / 4; i += (size_t)gridDim.x * 512) { const f32x4 v = *(const f32x4*)(p.in[I_MEM] + 4 * i); u32x2 w; w.x = pk2(v[0], v[1]); w.y = pk2(v[2], v[3]); *(u32x2*)(MEMB + 4 * i) = w; }
            }
        } else if (k == 2) {
            for (int m = gw; m < MTOK; m += NGW) { const int pos = m & (SEQ - 1); bf16_t* rowp = PJ + (size_t)m * PJW;
                unsigned xa[7], xb[7]; f32x4 cs[7];
#pragma unroll
                for (int i = 0; i < 7; ++i) { const int task = lane + 64 * i, hs = task >> 4, d = (task & 15) * 2;
                    const int cb = hs < 8 ? C_NQ + 64 * hs : hs < 12 ? C_KSLC + 64 * (hs - 8) : hs < 20 ? C_DQ + 64 * (hs - 12) : C_DK + 64 * (hs - 20);
                    xa[i] = *(const unsigned*)(rowp + cb + d); xb[i] = *(const unsigned*)(rowp + cb + d + 32); cs[i] = *(const f32x4*)(ROPE + (pos * 32 + d) * 2); }
#pragma unroll
                for (int i = 0; i < 7; ++i) { const int task = lane + 64 * i, hs = task >> 4, d = (task & 15) * 2;
                    const int cb = hs < 8 ? C_NQ + 64 * hs : hs < 12 ? C_KSLC + 64 * (hs - 8) : hs < 20 ? C_DQ + 64 * (hs - 12) : C_DK + 64 * (hs - 20);
                    const float a0 = bf2f((bf16_t)(xa[i] & 0xffffu)), a1 = bf2f((bf16_t)(xa[i] >> 16)), b0 = bf2f((bf16_t)(xb[i] & 0xffffu)), b1 = bf2f((bf16_t)(xb[i] >> 16));
                    *(unsigned*)(rowp + cb + d) = pk2(a0 * cs[i][0] - b0 * cs[i][1], a1 * cs[i][2] - b1 * cs[i][3]);
                    *(unsigned*)(rowp + cb + d + 32) = pk2(b0 * cs[i][0] + a0 * cs[i][1], b1 * cs[i][2] + a1 * cs[i][3]); } }
            for (int it = gw; it < 2 * 2032; it += NGW) { const int j = it / 2032, rr = it % 2032, g = rr & 1, bi = rr >> 1, b = bi / NCMP, ci = bi % NCMP;
                const float* pe = p.in[I_PE] + ((size_t)L * 2 + j) * 32 * 64; bf16_t* dst = CMPA + ((size_t)j * 2048 + rr) * DM;
#pragma unroll
                for (int q = 0; q < 4; ++q) { const int l = (lane >> 3) + 8 * q, d0 = 8 * (lane & 7);
                    const bf16x8 v = *(const bf16x8*)(PJ + ((size_t)b * SEQ + 16 * ci + l) * PJW + C_KCMP + j * 128 + g * 64 + d0);
                    const f32x4 e0 = *(const f32x4*)(pe + l * 64 + d0), e1 = *(const f32x4*)(pe + l * 64 + d0 + 4);
                    u32x4 w; w.x = pk2(bf2f((bf16_t)v[0]) + e0[0], bf2f((bf16_t)v[1]) + e0[1]); w.y = pk2(bf2f((bf16_t)v[2]) + e0[2], bf2f((bf16_t)v[3]) + e0[3]);
                    w.z = pk2(bf2f((bf16_t)v[4]) + e1[0], bf2f((bf16_t)v[5]) + e1[1]); w.w = pk2(bf2f((bf16_t)v[6]) + e1[2], bf2f((bf16_t)v[7]) + e1[3]);
                    *(u32x4*)(dst + l * 64 + d0) = w; } }
            for (int it = gw; it < 8 * 32 * 32; it += NGW) { const int ck = it & 31, g = (it >> 5) & 31, b = it >> 10; const int pst = lane;
                const size_t gp = ((size_t)L * 32 + g) * 64 + pst;
                const float lr = fminf(p.in[I_LRE][gp], -1e-4f), li = p.in[I_LIM][gp], dt = expf(p.in[I_LDT][L * 32 + g]);
                const float mag = expf(lr * dt); float sn, cs; sincos_acc(li * dt, sn, cs); const float are = mag * cs, aim = mag * sn;
                const float den = lr * lr + li * li, zre = ((are - 1.f) * lr + aim * li) / den, zim = (aim * lr - (are - 1.f) * li) / den;
                float bbr[16], bbi[16];
#pragma unroll
                for (int c4 = 0; c4 < 4; ++c4) { const f32x4 br = *(const f32x4*)(p.in[I_BRE] + gp * 16 + 4 * c4), bi = *(const f32x4*)(p.in[I_BIM] + gp * 16 + 4 * c4);
#pragma unroll
                    for (int e = 0; e < 4; ++e) { bbr[4 * c4 + e] = zre * br[e] - zim * bi[e]; bbi[4 * c4 + e] = zre * bi[e] + zim * br[e]; } }
                float xr = 0.f, xi = 0.f;
                float* Uf = (float*)lds_raw + wave * 1024;
                { const bf16_t* upl = PJ + ((size_t)b * SEQ + ck * 64 + lane) * PJW + C_U + g * 16; const bf16x8 ua = *(const bf16x8*)upl, ub = *(const bf16x8*)(upl + 8);
                  __builtin_amdgcn_wave_barrier();
                  f32x4 w0, w1, w2, w3;
#pragma unroll
                  for (int e = 0; e < 4; ++e) { w0[e] = bf2f((bf16_t)ua[e]); w1[e] = bf2f((bf16_t)ua[4 + e]); w2[e] = bf2f((bf16_t)ub[e]); w3[e] = bf2f((bf16_t)ub[4 + e]); }
                  f32x4* ud = (f32x4*)(Uf + lane * 16); ud[0] = w0; ud[1] = w1; ud[2] = w2; ud[3] = w3;
                  __builtin_amdgcn_wave_barrier(); }
                f32x2 bbp[16];
#pragma unroll
                for (int c = 0; c < 16; ++c) { bbp[c].x = bbr[c]; bbp[c].y = bbi[c]; }
#pragma unroll 8
                for (int tt = 0; tt < 64; ++tt) { const f32x4* up = (const f32x4*)(Uf + tt * 16);
                    const f32x4 u0 = up[0], u1 = up[1], u2 = up[2], u3 = up[3]; f32x2 a0 = {0.f, 0.f}, a1 = {0.f, 0.f};
#pragma unroll
                    for (int c = 0; c < 4; ++c) { a0 += bbp[c] * u0[c]; a1 += bbp[4 + c] * u1[c]; a0 += bbp[8 + c] * u2[c]; a1 += bbp[12 + c] * u3[c]; }
                    const float bur = a0.x + a1.x, bui = a0.y + a1.y;
                    const float nr = are * xr - aim * xi + bur, ni = are * xi + aim * xr + bui; xr = nr; xi = ni; }
                f32x2 e; e.x = xr; e.y = xi; S5E[(size_t)it * 64 + pst] = e; }
        } else if (k == 4) {
            for (int it = gw; it < 2 * 2032; it += NGW) { const int j = it / 2032, rr = it % 2032, g = rr & 1, bi = rr >> 1, b = bi / NCMP, ci = bi % NCMP;
                const bf16_t* hr = HC + ((size_t)j * 2048 + rr) * 256 + j * 128; const float* w2 = p.in[I_CW2] + ((size_t)L * 2 + j) * 128 * 64;
                float acc = 0.f;
#pragma unroll 4
                for (int kk = 0; kk < 128; kk += 8) { const bf16x8 hv = *(const bf16x8*)(hr + kk);
#pragma unroll
                    for (int e = 0; e < 8; ++e) acc += bf2f((bf16_t)hv[e]) * w2[(kk + e) * 64 + lane]; }
                if (j == 0) { const int pos = 16 * ci + 31, d = lane & 31; const float cs = ROPE[(pos * 32 + d) * 2], sn = ROPE[(pos * 32 + d) * 2 + 1];
                    const float other = xorl(acc, r | (h << 5), 32); const float o = lane < 32 ? acc * cs - other * sn : acc * cs + other * sn;
                    KC[((size_t)(b * 2 + g) * 128 + ci) * 64 + lane] = f2bf(o); }
                else VCT[((size_t)(b * 2 + g) * 64 + lane) * 128 + ci] = f2bf(acc); }
        } else if (k == 5) {
            if ((wave & 1) == 0) for (int u = blockIdx.x * 4 + (wave >> 1); u < 1024; u += gridDim.x * 4) { const int qt = 63 - (u >> 4), bg = u & 15; nsa_a_unit(PJ, KC, VCT, OCB, SEL, bg >> 1, bg & 1, qt, r, h, scr + wave * (2 * 32 * 33)); }
        } else if (k == 17) {
            for (int rp = 0; rp < 1 + ((MK_REP_SUB >> 0) & 1); ++rp)
            { bf16_t* XSb = (bf16_t*)lds_raw + wave * (16 * 136);
              const bool g256 = gridDim.x == 256; const int nui = g256 ? 5 : (1024 + (int)gridDim.x - 1) / (int)gridDim.x;
              for (int ui = 0; ui < nui; ++ui) { int bu;
                if (g256) { if (blockIdx.x < 16) { if (ui > 0) break; bu = 960 + (int)blockIdx.x; } else { const int bb = (int)blockIdx.x - 16; if (ui < 4) bu = bb + 240 * ui; else { if (bb >= 48) break; bu = 976 + bb; } } }
                else { bu = (int)blockIdx.x + ui * (int)gridDim.x; if (bu >= 1024) break; }
                const int kg = bu & 3, g = (bu >> 2) & 31, b = bu >> 7, ck = kg * 8 + wave;
                const size_t gp = ((size_t)L * 32 + g) * 64 + lane;
                const float lr = fminf(p.in[I_LRE][gp], -1e-4f), li = p.in[I_LIM][gp], dt = expf(p.in[I_LDT][L * 32 + g]);
                const float mag = expf(lr * dt); float sn, cs; sincos_acc(li * dt, sn, cs); const float are = mag * cs, aim = mag * sn;
                const float den = lr * lr + li * li, zre = ((are - 1.f) * lr + aim * li) / den, zim = (aim * lr - (are - 1.f) * li) / den;
                const float magL = expf(lr * dt * 64.f); float snL, csL; sincos_acc(li * dt * 64.f, snL, csL); const float aLr = magL * csL, aLi = magL * snL;
                float bbr[16], bbi[16];
#pragma unroll
                for (int c4 = 0; c4 < 4; ++c4) { const f32x4 br = *(const f32x4*)(p.in[I_BRE] + gp * 16 + 4 * c4), bi = *(const f32x4*)(p.in[I_BIM] + gp * 16 + 4 * c4);
#pragma unroll
                    for (int e = 0; e < 4; ++e) { bbr[4 * c4 + e] = zre * br[e] - zim * bi[e]; bbi[4 * c4 + e] = zre * bi[e] + zim * br[e]; } }
                const int c = lane & 15, quad = lane >> 4;
                bf16x8 cwf[4];
#pragma unroll
                for (int kk = 0; kk < 4; ++kk) { const int kb = 32 * kk + 8 * quad; const float* src = (kb < 64 ? p.in[I_CRE] : p.in[I_CIM]) + (((size_t)L * 32 + g) * 16 + c) * 64 + (kb & 63);
                    const f32x4 c0 = *(const f32x4*)src, c1 = *(const f32x4*)(src + 4); const float sg = kb < 64 ? 1.f : -1.f;
                    u32x4 w; w.x = pk2(sg * c0[0], sg * c0[1]); w.y = pk2(sg * c0[2], sg * c0[3]); w.z = pk2(sg * c1[0], sg * c1[1]); w.w = pk2(sg * c1[2], sg * c1[3]); cwf[kk] = __builtin_bit_cast(bf16x8, w); }
                float xr = 0.f, xi = 0.f;
#pragma unroll 8
                for (int jq = 0; jq < ck; ++jq) { const f32x2 e = S5E[((size_t)(b * 32 + g) * 32 + jq) * 64 + lane]; const float nr = aLr * xr - aLi * xi + e.x, ni = aLr * xi + aLi * xr + e.y; xr = nr; xi = ni; }
                const float dsk = p.in[I_SD][((size_t)L * 32 + g) * 16 + c];
                float* Uf = (float*)(lds_raw + 8 * (16 * 136) * 2) + wave * 1024;
                { const bf16_t* upl = PJ + ((size_t)b * SEQ + ck * 64 + lane) * PJW + C_U + g * 16; const bf16x8 ua = *(const bf16x8*)upl, ub = *(const bf16x8*)(upl + 8);
                  __builtin_amdgcn_wave_barrier();
                  f32x4 w0, w1, w2, w3;
#pragma unroll
                  for (int e = 0; e < 4; ++e) { w0[e] = bf2f((bf16_t)ua[e]); w1[e] = bf2f((bf16_t)ua[4 + e]); w2[e] = bf2f((bf16_t)ub[e]); w3[e] = bf2f((bf16_t)ub[4 + e]); }
                  f32x4* ud = (f32x4*)(Uf + lane * 16); ud[0] = w0; ud[1] = w1; ud[2] = w2; ud[3] = w3;
                  __builtin_amdgcn_wave_barrier(); }
                f32x2 bbp[16];
#pragma unroll
                for (int cq = 0; cq < 16; ++cq) { bbp[cq].x = bbr[cq]; bbp[cq].y = bbi[cq]; }
                for (int sc4 = 0; sc4 < 4; ++sc4) {
#pragma unroll 8
                    for (int tt = 0; tt < 16; ++tt) { const f32x4* up = (const f32x4*)(Uf + (sc4 * 16 + tt) * 16);
                        const f32x4 u0 = up[0], u1 = up[1], u2 = up[2], u3 = up[3]; f32x2 a0 = {0.f, 0.f}, a1 = {0.f, 0.f};
#pragma unroll
                        for (int cc = 0; cc < 4; ++cc) { a0 += bbp[cc] * u0[cc]; a1 += bbp[4 + cc] * u1[cc]; a0 += bbp[8 + cc] * u2[cc]; a1 += bbp[12 + cc] * u3[cc]; }
                        const float bur = a0.x + a1.x, bui = a0.y + a1.y;
                        const float nr = are * xr - aim * xi + bur, ni = are * xi + aim * xr + bui; xr = nr; xi = ni;
                        XSb[tt * 136 + lane] = f2bf(xr); XSb[tt * 136 + 64 + lane] = f2bf(xi); }
                    __builtin_amdgcn_wave_barrier();
                    f32x4 y = {0.f, 0.f, 0.f, 0.f};
#pragma unroll
                    for (int kk = 0; kk < 4; ++kk) { const bf16x8 xa = *(const bf16x8*)(XSb + c * 136 + 32 * kk + 8 * quad);
                        y = __builtin_amdgcn_mfma_f32_16x16x32_bf16(xa, cwf[kk], y, 0, 0, 0); }
                    __builtin_amdgcn_wave_barrier();
#pragma unroll
                    for (int i = 0; i < 4; ++i) { const size_t row = (size_t)b * SEQ + ck * 64 + sc4 * 16 + 4 * quad + i; const float uv = Uf[(sc4 * 16 + 4 * quad + i) * 16 + c];
                        GA[row * 512 + g * 16 + c] = f2bf(gelu_tanh(y[i] + dsk * uv)); }
                }
              }
              __syncthreads(); }
        } else if (k == 18 || k == 19) {
            for (int rp = 0; rp < 1 + ((k == 19) ? ((MK_REP_SUB >> 1) & 1) : 0); ++rp)
            for (int u = blockIdx.x; u < 512; u += gridDim.x) { const int bh = u & 63, qb = u < 256 ? 7 - (u >> 6) : (u >> 6) - 4, b = bh >> 3, head = bh & 7;
                const int t0 = qb * 256 + wave * 32, t = t0 + r; const size_t row = (size_t)b * SEQ + t;
                bf16x8 qf[4]; load_q<64>(qf, PJ + row * PJW + (k == 18 ? C_SBQ : C_DQ) + head * 64, h);
                f32x16 o[2];
#pragma unroll
                for (int i = 0; i < 16; ++i) { o[0][i] = 0.f; o[1][i] = 0.f; }
                float mx = -INFINITY, l = 0.f;
                if (k == 18) attn_block<AM_SB>(PJ + (size_t)b * SEQ * PJW + C_SBK + head * 64, VT + (size_t)(R_SBV + head * 64) * MTOK + (size_t)b * SEQ, (bf16_t*)lds_raw, qf, qb, t0, t, 0u, o, mx, l, wave, r, h, tid);
                else { attn_block<AM_DIL>(PJ + (size_t)b * SEQ * PJW + C_DK + head * 64, VT + (size_t)(R_DV + head * 64) * MTOK + (size_t)b * SEQ, (bf16_t*)lds_raw, qf, qb, t0, t, 0u, o, mx, l, wave, r, h, tid);
                    const float lt = l + xorl(l, r | (h << 5), 32); const float inv = lt > 0.f ? 1.f / lt : 0.f;
#pragma unroll
                    for (int i = 0; i < 16; ++i) { o[0][i] *= inv; o[1][i] *= inv; } }
                store_o<64>(YS + row * DM + (k == 18 ? 1024 : 1536) + head * 64, o, h);
            }
        } else if (k == 6) {
            for (int rp = 0; rp < 1 + ((MK_REP_SUB >> 2) & 1); ++rp)
            for (int u = blockIdx.x; u < 512; u += gridDim.x) { const int bh = u & 63, qb = u < 256 ? 7 - (u >> 6) : (u >> 6) - 4, b = bh >> 3, head = bh & 7, g = head >> 2;
                const int t0 = qb * 256 + wave * 32, t = t0 + r; const size_t row = (size_t)b * SEQ + t;
                bf16x8 qf[4]; load_q<64>(qf, PJ + row * PJW + C_NQ + head * 64, h);
                const unsigned mask = SEL[row * 2 + g];
                f32x16 o[2], os[2];
#pragma unroll
                for (int i = 0; i < 16; ++i) { o[0][i] = 0.f; o[1][i] = 0.f; }
                float mx = -INFINITY, l = 0.f;
                attn_block<AM_SEL>(PJ + (size_t)b * SEQ * PJW + C_KSLC + g * 64, VT + (size_t)(R_VSLC + g * 64) * MTOK + (size_t)b * SEQ, (bf16_t*)lds_raw, qf, qb, t0, t, mask, o, mx, l, wave, r, h, tid);
                const float g1 = sigmoidf_(bf2f(PJ[row * PJW + C_GATE + head * 3 + 1])), g2 = sigmoidf_(bf2f(PJ[row * PJW + C_GATE + head * 3 + 2]));
                { const float lt = l + xorl(l, r | (h << 5), 32); const float inv = lt > 0.f ? g1 / lt : 0.f;
#pragma unroll
                  for (int i = 0; i < 16; ++i) { os[0][i] = o[0][i] * inv; os[1][i] = o[1][i] * inv; o[0][i] = 0.f; o[1][i] = 0.f; } }
                mx = -INFINITY; l = 0.f;
                attn_block<AM_WIN>(PJ + (size_t)b * SEQ * PJW + C_KWIN + g * 64, VT + (size_t)(R_VWIN + g * 64) * MTOK + (size_t)b * SEQ, (bf16_t*)lds_raw, qf, qb, t0, t, 0u, o, mx, l, wave, r, h, tid);
                { const float lt = l + xorl(l, r | (h << 5), 32); const float inv = lt > 0.f ? g2 / lt : 0.f;
                  const bf16_t* ocr = OCB + row * 512 + head * 64;
#pragma unroll
                  for (int db = 0; db < 2; ++db)
#pragma unroll
                      for (int jj = 0; jj < 4; ++jj) { const s16x4 cv = *(const s16x4*)(ocr + 32 * db + 8 * jj + 4 * h);
#pragma unroll
                          for (int e = 0; e < 4; ++e) o[db][4 * jj + e] = o[db][4 * jj + e] * inv + os[db][4 * jj + e] + bf2f((bf16_t)cv[e]); } }
                store_o<64>(YS + row * DM + 512 + head * 64, o, h);
            }
        } else if (k == 7) {
            for (int m = gw; m < MTOK / 2; m += NGW) {
                bf16x8 v[2][4]; float ss[2][4];
#pragma unroll
                for (int q = 0; q < 2; ++q)
#pragma unroll
                    for (int gq = 0; gq < 4; ++gq) v[q][gq] = *(const bf16x8*)(YS + ((size_t)m + (size_t)q * (MTOK / 2)) * DM + gq * 512 + 8 * lane);
#pragma unroll
                for (int q = 0; q < 2; ++q)
#pragma unroll
                    for (int gq = 0; gq < 4; ++gq) { float a = 0.f;
#pragma unroll
                        for (int e = 0; e < 8; ++e) { const float f = bf2f((bf16_t)v[q][gq][e]); a += f * f; } ss[q][gq] = a; }
#pragma unroll
                for (int o = 1; o < 64; o <<= 1)
#pragma unroll
                    for (int q = 0; q < 2; ++q)
#pragma unroll
                        for (int gq = 0; gq < 4; ++gq) ss[q][gq] += xorl(ss[q][gq], lane, o);
#pragma unroll
                for (int gq = 0; gq < 4; ++gq) { const float* ng = p.in[I_NG] + ((size_t)L * 4 + gq) * 512 + 8 * lane; const f32x4 n0 = *(const f32x4*)ng, n1 = *(const f32x4*)(ng + 4);
#pragma unroll
                    for (int q = 0; q < 2; ++q) { const float rs = 1.f / sqrtf(ss[q][gq] * (1.f / 512.f) + RMS_EPS); float f[8];
#pragma unroll
                        for (int e = 0; e < 8; ++e) f[e] = bf2f((bf16_t)v[q][gq][e]) * rs;
                        u32x4 w; w.x = pk2(f[0] * n0[0], f[1] * n0[1]); w.y = pk2(f[2] * n0[2], f[3] * n0[3]); w.z = pk2(f[4] * n1[0], f[5] * n1[1]); w.w = pk2(f[6] * n1[2], f[7] * n1[3]);
                        *(u32x4*)(YS + ((size_t)m + (size_t)q * (MTOK / 2)) * DM + gq * 512 + 8 * lane) = w; } } }
        } else if (k == 9 || k == 13 || k == 16) {
            const int gi = k == 9 ? I_L1G : k == 13 ? I_L2G : I_L3G; const bool fin = (k == 16 && L == DEPTH - 1);
            for (int m = gw; m < MTOK / 4; m += NGW) ln_rows_b<4>((const bf16_t*)HF + (size_t)m * DM, (size_t)(MTOK / 4) * DM, p.in[gi] + (size_t)L * DM, p.in[gi + 1] + (size_t)L * DM, fin ? nullptr : HB + (size_t)m * DM, fin ? p.out + (size_t)m * DM : nullptr, lane);
            if (k == 13) { wconv_phase(p, ws, L, scr + wave * (64 * 65), lane, 1, gw, NGW, gridDim.x == 256 ? GU_EARLY : 0, 1 << 30); if (gridDim.x != 256) wconv_phase(p, ws, L, scr + wave * (64 * 65), lane, 2, gw, NGW, 0, 1 << 30); }
        } else if (k == 3) {
            if (gridDim.x == 256 && blockIdx.x >= 16) { wconv_phase(p, ws, L, scr + wave * (64 * 65), lane, 2, ((int)blockIdx.x - 16) * 8 + wave, 240 * 8, 0, 1 << 30);
                wconv_phase(p, ws, L, scr + wave * (64 * 65), lane, 1, ((int)blockIdx.x - 16) * 8 + wave, 240 * 8, 0, GU_EARLY); }
        } else if (k == 11) {
            for (int u = blockIdx.x; u < 256; u += gridDim.x) { const int bh = u & 31, qb = u >> 5; xatt_block(QX, KX, KXT, OX, (bf16_t*)lds_raw, bh >> 2, bh & 3, qb, wave, r, h, tid); }
        }
        if (ph2 + 1 < 2 * ph_hi) { if (sync_after) { if (ph_lo < 0) grid.sync(); else xcd_barrier(xbar); } else __syncthreads(); }
    }
}

__global__ void diag_k(float* out, float code) { if (threadIdx.x == 0) out[0] = code; }
extern "C" void kernel_launch(void* const* d_in, const int* in_sizes, int n_in, void* d_out, int out_size, void* d_ws, size_t ws_size, hipStream_t stream) {
    static int grid = 0;
    if (grid == 0) {
        if (n_in != 32 || ws_size < WS_END) { fprintf(stderr, "kernel_launch: bad inputs n_in %d ws %zu need %zu\n", n_in, ws_size, (size_t)WS_END); grid = -1; }
        if (grid == 0) {
        int dev = 0, cus = 0, per_cu = 0;
        hipGetDevice(&dev); hipDeviceGetAttribute(&cus, hipDeviceAttributeMultiprocessorCount, dev);
        hipFuncSetAttribute((const void*)mk_fwd, hipFuncAttributeMaxDynamicSharedMemorySize, LDS_BYTES);
        hipOccupancyMaxActiveBlocksPerMultiprocessor(&per_cu, (const void*)mk_fwd, 512, LDS_BYTES);
        if (per_cu < 1) per_cu = 1;
        (void)hipGetLastError();
        grid = cus * 1;
        fprintf(stderr, "kernel_launch: grid %d (occupancy %d/CU)\n", grid, per_cu);
        }
    }
    if (grid < 0) { diag_k<<<1, 64, 0, stream>>>((float*)d_out, (n_in == 32 ? (float)(ws_size >> 20) : 1e6f)); return; }
    (void)hipMemsetAsync((char*)d_ws + WS_BAR, 0, WS_BAR_BYTES, stream);
    Params p{};
    for (int i = 0; i < 32; ++i) p.in[i] = (const float*)d_in[i];
    p.out = (float*)d_out; p.ws = (unsigned char*)d_ws;
#ifndef MK_HI
#define MK_HI N_PHASES
#endif
    int lo = 0, hi = MK_HI;
    void* args[] = {&p, &lo, &hi};
    hipError_t e = hipLaunchCooperativeKernel((const void*)mk_fwd, dim3(grid), dim3(512), args, LDS_BYTES, stream);
    if (e != hipSuccess) { fprintf(stderr, "cooperative launch failed: %s (grid %d)\n", hipGetErrorString(e), grid); (void)hipGetLastError(); diag_k<<<1, 64, 0, stream>>>((float*)d_out, 200000.f + (float)(int)e); }
}
```
